# Optimizing an MI355X kernel written in HIP

```python
import math
import jax, jax.numpy as jnp
from jax import lax
import numpy as np


D_MODEL = 1024
BATCH = 4
SEQ = 4096
DEPTH = 4

HEAD_DIM = 64
A_GROUPS = 4
A_WIDTH = A_GROUPS * HEAD_DIM
CHUNK = 128
B_HEADS = 6
B_WIDTH = B_HEADS * HEAD_DIM
DIL_PAIRS = ((128, 1), (512, 4), (2048, 16))
C_HEADS_PER_GROUP = 2
C_GROUPS = len(DIL_PAIRS)
C_HEADS = C_GROUPS * C_HEADS_PER_GROUP
C_WIDTH = C_HEADS * HEAD_DIM
C_DILATIONS = tuple(d for (w, d) in DIL_PAIRS for _ in range(C_HEADS_PER_GROUP))
N_OFFSETS = DIL_PAIRS[0][0] // DIL_PAIRS[0][1] + 1
MIX_WIDTH = A_WIDTH + B_WIDTH + C_WIDTH
IN_WIDTH = 2 * A_WIDTH + 3 * B_WIDTH + 3 * C_WIDTH
Q_BLOCK = 128
D_FF = 2816
CONV_WIDTH = 3
ROPE_THETA = 10000.0
EPS = 1e-6
N_MOD = 6

kernel_name = 'hybrid_sgu_stickbreak_dilated_convffn_adaln'


def _rmsnorm(x, g):
    x32 = x.astype(jnp.float32)
    y = x32 * lax.rsqrt(jnp.mean(x32 * x32, axis=-1, keepdims=True) + EPS)
    return (y * g.astype(jnp.float32)).astype(x.dtype)


def _rope_tables(positions):
    inv_freq = ROPE_THETA ** (-jnp.arange(0, HEAD_DIM, 2, dtype=jnp.float32) / HEAD_DIM)
    ang = positions.astype(jnp.float32)[..., None] * inv_freq
    return jnp.cos(ang)[:, :, None, :], jnp.sin(ang)[:, :, None, :]


def _rope(x, cos, sin):
    x32 = x.astype(jnp.float32)
    x1, x2 = jnp.split(x32, 2, axis=-1)
    return jnp.concatenate([x1 * cos - x2 * sin, x2 * cos + x1 * sin], axis=-1).astype(x.dtype)


def _spatial_gating(u, v, g_sgu, w_sp, b_sp):
    bsz, seq, _ = u.shape
    n_chunks = seq // CHUNK
    u = jax.nn.gelu(u)
    v = jax.nn.gelu(v).reshape(bsz, n_chunks, CHUNK, A_GROUPS, HEAD_DIM)
    v = _rmsnorm(v, g_sgu.reshape(A_GROUPS, HEAD_DIM))
    causal = jnp.tril(jnp.ones((CHUNK, CHUNK), dtype=bool))
    w_causal = jnp.where(causal[None], w_sp, 0.0).astype(v.dtype)
    mixed = jnp.einsum('gts,bnsgc->bntgc', w_causal, v) + b_sp.T[:, :, None].astype(v.dtype)
    return u * mixed.reshape(bsz, seq, A_WIDTH)


def _stick_breaking(q, k, v):
    bsz, seq, n_heads, dh = q.shape
    n_blocks = seq // Q_BLOCK
    scale = dh ** -0.5
    k_pos = jnp.arange(seq)
    q_blocks = q.reshape(bsz, n_blocks, Q_BLOCK, n_heads, dh).transpose(1, 0, 2, 3, 4)

    def one_block(args):
        q_blk, blk = args
        q_pos = blk * Q_BLOCK + jnp.arange(Q_BLOCK)
        before = (k_pos[None, :] < q_pos[:, None])[None, None]
        z = jnp.einsum('bqhd,bkhd->bhqk', q_blk, k).astype(jnp.float32) * scale
        log_beta = jax.nn.log_sigmoid(z)
        log_stay = jnp.where(before, jax.nn.log_sigmoid(-z), 0.0)
        tail = lax.cumsum(log_stay, axis=3, reverse=True) - log_stay
        weight = jnp.where(before, jnp.exp(log_beta + tail), 0.0)
        return jnp.einsum('bhqk,bkhd->bqhd', weight.astype(v.dtype), v)

    out = lax.map(one_block, (q_blocks, jnp.arange(n_blocks)))
    return out.transpose(1, 0, 2, 3, 4).reshape(bsz, seq, n_heads * dh)


def _dilated_window(q, k, v):
    bsz, seq, n_heads, dh = q.shape
    n_blocks = seq // Q_BLOCK
    scale = dh ** -0.5
    dil = jnp.array(C_DILATIONS, dtype=jnp.int32)
    offsets = jnp.arange(N_OFFSETS, dtype=jnp.int32)
    head_idx = jnp.arange(n_heads)[None, None, :]
    q_blocks = q.reshape(bsz, n_blocks, Q_BLOCK, n_heads, dh).transpose(1, 0, 2, 3, 4)

    def one_block(args):
        q_blk, blk = args
        q_pos = blk * Q_BLOCK + jnp.arange(Q_BLOCK, dtype=jnp.int32)
        idx = q_pos[:, None, None] - offsets[None, :, None] * dil[None, None, :]
        valid = idx >= 0
        idx = jnp.maximum(idx, 0)
        k_g = k[:, idx, head_idx, :]
        v_g = v[:, idx, head_idx, :]
        z = jnp.einsum('bqhd,bqmhd->bqhm', q_blk, k_g).astype(jnp.float32) * scale
        z = jnp.where(valid.transpose(0, 2, 1)[None], z, -jnp.inf)
        z_max = jnp.max(z, axis=-1, keepdims=True)
        p = jnp.exp(z - z_max)
        denom = jnp.sum(p, axis=-1)
        o = jnp.einsum('bqhm,bqmhd->bqhd', p.astype(v.dtype), v_g) / denom[..., None]
        return o.astype(q.dtype), z_max[..., 0] + jnp.log(denom)

    o, lse = lax.map(one_block, (q_blocks, jnp.arange(n_blocks)))
    o = o.transpose(1, 0, 2, 3, 4).reshape(bsz, seq, C_GROUPS, C_HEADS_PER_GROUP, dh)
    lse = lse.transpose(1, 0, 2, 3).reshape(bsz, seq, C_GROUPS, C_HEADS_PER_GROUP)
    alpha = jax.nn.softmax(lse, axis=2)
    return (o * alpha[..., None].astype(o.dtype)).reshape(bsz, seq, n_heads * dh)


def _causal_dwconv(h, w, b):
    seq = h.shape[1]
    hp = jnp.pad(h, ((0, 0), (CONV_WIDTH - 1, 0), (0, 0)))
    out = b.astype(h.dtype)
    for i in range(CONV_WIDTH):
        out = out + w[i].astype(h.dtype) * hp[:, i:i + seq]
    return out


def setup_inputs(seed: int = 0) -> dict:
    key = jax.random.key(seed)
    ks = jax.random.split(key, 17)
    f32 = jnp.float32

    def nrm(k, shape, s):
        return jax.random.normal(k, shape, f32) * s

    x = nrm(ks[0], (BATCH, SEQ, D_MODEL), 1.0)
    c = nrm(ks[1], (BATCH, D_MODEL), 1.0)
    offset = jax.random.randint(ks[2], (BATCH, 1), 0, 1024, dtype=jnp.int32)
    positions = jnp.arange(SEQ, dtype=jnp.int32)[None, :] + offset
    w_ada = nrm(ks[3], (DEPTH, D_MODEL, N_MOD * D_MODEL), 0.2 * D_MODEL ** -0.5)
    b_ada = nrm(ks[4], (DEPTH, N_MOD * D_MODEL), 0.02)
    g_mix = 1.0 + nrm(ks[5], (DEPTH, D_MODEL), 0.05)
    w_in = nrm(ks[6], (DEPTH, D_MODEL, IN_WIDTH), D_MODEL ** -0.5)
    g_sgu = 1.0 + nrm(ks[7], (DEPTH, A_WIDTH), 0.05)
    w_sp = nrm(ks[8], (DEPTH, A_GROUPS, CHUNK, CHUNK), CHUNK ** -0.5)
    b_sp = 1.0 + nrm(ks[9], (DEPTH, A_GROUPS, CHUNK), 0.1)
    w_out = nrm(ks[10], (DEPTH, MIX_WIDTH, D_MODEL), MIX_WIDTH ** -0.5)
    g_ffn = 1.0 + nrm(ks[11], (DEPTH, D_MODEL), 0.05)
    w_up = nrm(ks[12], (DEPTH, D_MODEL, 2 * D_FF), D_MODEL ** -0.5)
    conv_w = nrm(ks[13], (DEPTH, CONV_WIDTH, 2 * D_FF), CONV_WIDTH ** -0.5)
    conv_b = nrm(ks[14], (DEPTH, 2 * D_FF), 0.02)
    w_down = nrm(ks[15], (DEPTH, D_FF, D_MODEL), D_FF ** -0.5)
    g_final = 1.0 + nrm(ks[16], (D_MODEL,), 0.05)
    return {'x': x, 'c': c, 'positions': positions, 'w_ada': w_ada, 'b_ada': b_ada,
            'g_mix': g_mix, 'w_in': w_in, 'g_sgu': g_sgu, 'w_sp': w_sp, 'b_sp': b_sp,
            'w_out': w_out, 'g_ffn': g_ffn, 'w_up': w_up, 'conv_w': conv_w,
            'conv_b': conv_b, 'w_down': w_down, 'g_final': g_final}


def reference(x, c, positions, w_ada, b_ada, g_mix, w_in, g_sgu, w_sp, b_sp, w_out,
              g_ffn, w_up, conv_w, conv_b, w_down, g_final):
    bsz, seq, _ = x.shape
    cos, sin = _rope_tables(positions)
    splits = np.cumsum([A_WIDTH, A_WIDTH, B_WIDTH, B_WIDTH, B_WIDTH, C_WIDTH, C_WIDTH]).tolist()
    c_act = jax.nn.silu(c)
    for l in range(DEPTH):
        mod = (c_act @ w_ada[l] + b_ada[l])[:, None, :]
        shift1, scale1, gate1, shift2, scale2, gate2 = jnp.split(mod, N_MOD, axis=-1)
        h = _rmsnorm(x, g_mix[l]) * (1.0 + scale1) + shift1
        proj = h @ w_in[l]
        a_u, a_v, b_q, b_k, b_v, c_q, c_k, c_v = jnp.split(proj, splits, axis=-1)
        y_a = _spatial_gating(a_u, a_v, g_sgu[l], w_sp[l], b_sp[l])
        y_b = _stick_breaking(b_q.reshape(bsz, seq, B_HEADS, HEAD_DIM),
                              b_k.reshape(bsz, seq, B_HEADS, HEAD_DIM),
                              b_v.reshape(bsz, seq, B_HEADS, HEAD_DIM))
        y_c = _dilated_window(_rope(c_q.reshape(bsz, seq, C_HEADS, HEAD_DIM), cos, sin),
                              _rope(c_k.reshape(bsz, seq, C_HEADS, HEAD_DIM), cos, sin),
                              c_v.reshape(bsz, seq, C_HEADS, HEAD_DIM))
        y = jnp.concatenate([y_a, y_b, y_c], axis=-1) @ w_out[l]
        x = x + (1.0 + gate1) * y
        h = _rmsnorm(x, g_ffn[l]) * (1.0 + scale2) + shift2
        up = _causal_dwconv(h @ w_up[l], conv_w[l], conv_b[l])
        gate, val = jnp.split(up, 2, axis=-1)
        x = x + (1.0 + gate2) * ((jax.nn.silu(gate) * val) @ w_down[l])
    return _rmsnorm(x, g_final)
```

```cpp
#include <hip/hip_runtime.h>
#include <hip/hip_cooperative_groups.h>
#include <cstdio>
#include <cstdint>
#include <cmath>
namespace cg = cooperative_groups;
namespace pg8 {
#define PG8_LAS __attribute__((address_space(3)))
typedef unsigned short bf16_t;
typedef short bf16x8 __attribute__((ext_vector_type(8)));
typedef float f32x4 __attribute__((ext_vector_type(4)));
typedef unsigned u32x4 __attribute__((ext_vector_type(4)));
constexpr int BM = 256, BK = 64, HALF = 128, HTB = HALF * BK * 2  , STAGE_BYTES = 8 * HTB, NXCD = 8, WGM = 8;

__host__ __device__ __forceinline__ int lds_byte(int r, int c) { const int st = (r >> 4) * 2 + (c >> 5), rr = r & 15, cc = c & 31, ob = rr * 64 + cc * 2; return st * 1024 + (ob ^ (((ob >> 9) & 1) << 5)); }
__host__ __device__ __forceinline__ void stage_rc(int b, int& R, int& C) { const int st = b / 1024, sb = b % 1024, swz = sb ^ (((sb >> 9) & 1) << 5); R = (st >> 1) * 16 + swz / 64; C = (st & 1) * 32 + (swz % 64) / 2; }
__host__ __device__ __forceinline__ int perm32(int rho) { const int n = rho >> 4, i = rho & 15; return 8 * (i >> 2) + 4 * n + (i & 3); }

struct Unit { int pm, pn; };
struct Gemm { const bf16_t* A; const bf16_t* Bt; int M, N, K; };

struct StaticOrder {
    int nM, nN, nwg, G, c;
    __host__ __device__ void init(int M, int N, int G_, int c_) { nM = M / BM; nN = N / BM; nwg = nM * nN; G = G_; c = c_; }
    __host__ __device__ bool next(int i, Unit& u) const {
        const long L = (long)i * G + c; if (L >= nwg) return false;
        int wgid = (int)L; { const int q = nwg / NXCD, r = nwg % NXCD, xcd = wgid % NXCD, off = wgid / NXCD; wgid = (xcd < r ? xcd * (q + 1) : r * (q + 1) + (xcd - r) * q) + off; }
        const int nig = WGM * nN, gid = wgid / nig, fm = gid * WGM, gsz = (nM - fm) < WGM ? (nM - fm) : WGM;
        u.pm = fm + ((wgid % nig) % gsz); u.pn = (wgid % nig) / gsz; return true;
    }
    __device__ __forceinline__ void a_ready(const Unit&) const {}
    __device__ __forceinline__ void done(const Unit&) const {}
};

template <class Epi, class Sched, bool ALIGN_EPI = false, bool SP2 = false>
__device__ __forceinline__ void gemm_phase(PG8_LAS unsigned char* lds, const Gemm g, const Sched& S, const Epi& E) {
    int tid_l = threadIdx.x; asm volatile("" : "+v"(tid_l));
    const int tid = tid_l, wid = __builtin_amdgcn_readfirstlane(tid >> 6), lane = tid & 63, wr = wid >> 2, wc = wid & 3, fr = lane & 15, fq = lane >> 4;
    const int K = g.K, nt = K / BK;
    unsigned voffA[2], voffB[2];
#pragma unroll
    for (int i = 0; i < 2; ++i) { int R, C; stage_rc(tid * 16 + i * 8192, R, C); const int Rb = Epi::PERM ? ((R & ~31) + perm32(R & 31)) : R;
        voffA[i] = (unsigned)(R * K + C) * 2u; voffB[i] = (unsigned)(Rb * K + C) * 2u; }
    const size_t kstep = (size_t)(BK * 2);
    const size_t hstep = (size_t)HALF * K * 2;
    const size_t tstep = 2 * hstep;
    const unsigned ldsw = (unsigned)wid * 1024u;
    const int aoff = lds_byte(wr * 64 + fr, fq * 8), boff = lds_byte(wc * 32 + fr, fq * 8);
#define PG8_SA(b, h) (((b) * 2 + (h)) * HTB)
#define PG8_SB(b, h) ((4 + (b) * 2 + (h)) * HTB)
#define PG8_STAGE(bufoff, gbase, voff) do { _Pragma("unroll") for (int _i = 0; _i < 2; ++_i) \
        __builtin_amdgcn_global_load_lds((const unsigned*)((const char*)(gbase) + (voff)[_i]), (PG8_LAS unsigned*)(lds + (bufoff) + ldsw + _i * 8192), 16, 0, 0); } while (0)
#define PG8_LDA(dst, b, h) do { _Pragma("unroll") for (int m = 0; m < 4; ++m) _Pragma("unroll") for (int k = 0; k < 2; ++k) dst[m][k] = *(const PG8_LAS bf16x8*)(lds + PG8_SA(b, h) + aoff + m * 2048 + k * 1024); } while (0)
#define PG8_LDB(dst, b, h) do { _Pragma("unroll") for (int n = 0; n < 2; ++n) _Pragma("unroll") for (int k = 0; k < 2; ++k) dst[n][k] = *(const PG8_LAS bf16x8*)(lds + PG8_SB(b, h) + boff + n * 2048 + k * 1024); } while (0)
#define PG8_MMA(ai, bj, At, Bt) do { __builtin_amdgcn_s_setprio(1); _Pragma("unroll") for (int m = 0; m < 4; ++m) _Pragma("unroll") for (int n = 0; n < 2; ++n) _Pragma("unroll") for (int k = 0; k < 2; ++k) \
        acc[ai][bj][m][n] = __builtin_amdgcn_mfma_f32_16x16x32_bf16(Bt[n][k], At[m][k], acc[ai][bj][m][n], 0, 0, 0); __builtin_amdgcn_s_setprio(0); } while (0)
#define PG8_WAIT_V(n) asm volatile("s_waitcnt vmcnt(" #n ")" ::: "memory")
#define PG8_WAIT_L(n) asm volatile("s_waitcnt lgkmcnt(" #n ")" ::: "memory")
#define PG8_BAR __builtin_amdgcn_s_barrier()
#define PG8_SCHED __builtin_amdgcn_sched_barrier(0)
    Unit cur, nxt; int ui = 0;
    if (!S.next(0, cur)) return;
    f32x4 acc[2][2][4][2];
#pragma unroll
    for (int a = 0; a < 2; ++a)
#pragma unroll
        for (int b = 0; b < 2; ++b)
#pragma unroll
            for (int m = 0; m < 4; ++m)
#pragma unroll
                for (int n = 0; n < 2; ++n) acc[a][b][m][n] = (f32x4){0.f, 0.f, 0.f, 0.f};
    bf16x8 At[4][2], B0[2][2], B1[2][2];
    const char* cA = (const char*)g.A + (size_t)cur.pm * tstep; const char* cB = (const char*)g.Bt + (size_t)cur.pn * tstep;
    S.a_ready(cur);
    if constexpr (SP2) {
        PG8_STAGE(PG8_SB(0, 0), cB, voffB); PG8_STAGE(PG8_SB(0, 1), cB + hstep, voffB); PG8_STAGE(PG8_SA(0, 0), cA, voffA); PG8_STAGE(PG8_SA(0, 1), cA + hstep, voffA);
        if (wr == 1) PG8_BAR;
        PG8_WAIT_V(2); PG8_BAR;
        PG8_STAGE(PG8_SB(1, 0), cB + kstep, voffB); PG8_STAGE(PG8_SA(1, 0), cA + kstep, voffA); PG8_STAGE(PG8_SB(1, 1), cB + hstep + kstep, voffB);
        PG8_WAIT_V(6); PG8_BAR;
    } else {
        PG8_STAGE(PG8_SB(0, 0), cB, voffB); PG8_STAGE(PG8_SA(0, 0), cA, voffA); PG8_STAGE(PG8_SB(0, 1), cB + hstep, voffB); PG8_STAGE(PG8_SA(0, 1), cA + hstep, voffA);
        if (wr == 1) PG8_BAR;
        PG8_WAIT_V(4); PG8_BAR;
        PG8_STAGE(PG8_SB(1, 0), cB + kstep, voffB); PG8_STAGE(PG8_SA(1, 0), cA + kstep, voffA); PG8_STAGE(PG8_SB(1, 1), cB + hstep + kstep, voffB);
        PG8_WAIT_V(6); PG8_BAR;
    }
    for (;;) {
        const bool has_next = S.next(ui + 1, nxt);
        const char* nA = has_next ? (const char*)g.A + (size_t)nxt.pm * tstep : cA; const char* nB = has_next ? (const char*)g.Bt + (size_t)nxt.pn * tstep : cB;
        for (int t = 0; t < nt; t += 2) {
            const bool last = (t == nt - 2);
            const char* a1 = cA + (size_t)(t + 1) * kstep;
            const char* a2 = last ? nA : cA + (size_t)(t + 2) * kstep; const char* b2 = last ? nB : cB + (size_t)(t + 2) * kstep;
            const char* a3 = a2 + kstep; const char* b3 = b2 + kstep;
            if (last && has_next) S.a_ready(nxt);
            if constexpr (SP2) {
            PG8_LDB(B0, 0, 0); PG8_LDB(B1, 0, 1); PG8_SCHED; PG8_LDA(At, 0, 0); PG8_STAGE(PG8_SA(1, 1), a1 + hstep, voffA);
            PG8_WAIT_V(8); PG8_WAIT_L(0); PG8_BAR; PG8_MMA(0, 0, At, B0); PG8_MMA(0, 1, At, B1); PG8_BAR; PG8_SCHED;
            PG8_LDA(At, 0, 1); PG8_STAGE(PG8_SB(0, 0), b2, voffB); PG8_STAGE(PG8_SB(0, 1), b2 + hstep, voffB); PG8_STAGE(PG8_SA(0, 0), a2, voffA);
            PG8_WAIT_V(8); PG8_WAIT_L(0); PG8_BAR; PG8_MMA(1, 0, At, B0); PG8_MMA(1, 1, At, B1); PG8_BAR; PG8_SCHED;
            PG8_LDB(B0, 1, 0); PG8_LDB(B1, 1, 1); PG8_SCHED; PG8_LDA(At, 1, 0); PG8_STAGE(PG8_SA(0, 1), a2 + hstep, voffA);
            PG8_WAIT_V(8); PG8_WAIT_L(0); PG8_BAR; PG8_MMA(0, 0, At, B0); PG8_MMA(0, 1, At, B1); PG8_BAR; PG8_SCHED;
            PG8_LDA(At, 1, 1); PG8_STAGE(PG8_SB(1, 0), b3, voffB); PG8_STAGE(PG8_SB(1, 1), b3 + hstep, voffB); PG8_STAGE(PG8_SA(1, 0), a3, voffA);
            PG8_WAIT_V(8); PG8_WAIT_L(0); PG8_BAR; PG8_MMA(1, 0, At, B0); PG8_MMA(1, 1, At, B1); PG8_BAR; PG8_SCHED;
            } else {
            PG8_LDB(B0, 0, 0); PG8_SCHED; PG8_LDA(At, 0, 0); PG8_STAGE(PG8_SA(1, 1), a1 + hstep, voffA);
            PG8_WAIT_L(8); PG8_BAR; PG8_WAIT_L(0); PG8_MMA(0, 0, At, B0); PG8_BAR; PG8_SCHED;
            PG8_LDB(B1, 0, 1); PG8_STAGE(PG8_SB(0, 0), b2, voffB);
            PG8_BAR; PG8_WAIT_L(0); PG8_MMA(0, 1, At, B1); PG8_BAR;
            PG8_LDA(At, 0, 1); PG8_STAGE(PG8_SA(0, 0), a2, voffA);
            PG8_BAR; PG8_WAIT_L(0); PG8_MMA(1, 0, At, B0); PG8_BAR; PG8_SCHED;
            PG8_STAGE(PG8_SB(0, 1), b2 + hstep, voffB);
            PG8_WAIT_V(6); PG8_BAR; PG8_MMA(1, 1, At, B1); PG8_BAR;
            PG8_LDB(B0, 1, 0); PG8_SCHED; PG8_LDA(At, 1, 0); PG8_STAGE(PG8_SA(0, 1), a2 + hstep, voffA);
            PG8_WAIT_L(8); PG8_BAR; PG8_WAIT_L(0); PG8_MMA(0, 0, At, B0); PG8_BAR; PG8_SCHED;
            PG8_LDB(B1, 1, 1); PG8_STAGE(PG8_SB(1, 0), b3, voffB);
            PG8_BAR; PG8_WAIT_L(0); PG8_MMA(0, 1, At, B1); PG8_BAR;
            PG8_LDA(At, 1, 1); PG8_STAGE(PG8_SA(1, 0), a3, voffA);
            PG8_BAR; PG8_WAIT_L(0); PG8_MMA(1, 0, At, B0); PG8_BAR; PG8_SCHED;
            PG8_STAGE(PG8_SB(1, 1), b3 + hstep, voffB);
            PG8_WAIT_V(6); PG8_BAR; PG8_MMA(1, 1, At, B1); PG8_BAR;
            }
        }
        if constexpr (ALIGN_EPI) { if (wr == 0) PG8_BAR; }
        if constexpr (!Epi::AFTER_DRAIN) { E(acc, cur, wr, wc, fr, fq, ui); S.done(cur); }
        if (!has_next) break;
#pragma unroll
        for (int a = 0; a < 2; ++a)
#pragma unroll
            for (int b = 0; b < 2; ++b)
#pragma unroll
                for (int m = 0; m < 4; ++m)
#pragma unroll
                    for (int n = 0; n < 2; ++n) acc[a][b][m][n] = (f32x4){0.f, 0.f, 0.f, 0.f};
        cur = nxt; cA = nA; cB = nB; ++ui;
        if constexpr (ALIGN_EPI) { if (wr == 1) PG8_BAR; }
    }
    PG8_WAIT_V(0);
    if constexpr (!ALIGN_EPI) { if (wr == 0) PG8_BAR; }
    PG8_BAR;
    if constexpr (Epi::AFTER_DRAIN) { E.fused(acc, cur, wr, wc, fr, fq, lds, wid, lane); S.done(cur); }
#undef PG8_SA
#undef PG8_SB
#undef PG8_STAGE
#undef PG8_LDA
#undef PG8_LDB
#undef PG8_MMA
#undef PG8_WAIT_V
#undef PG8_WAIT_L
#undef PG8_BAR
#undef PG8_SCHED
}
}

#ifndef PG8_SP2
#define PG8_SP2 true
#endif
#ifndef PG8_ALIGN
#define PG8_ALIGN true
#endif
constexpr int D = 1024, NB = 4, S = 4096, M = NB * S, DEPTH = 4;
constexpr int INW = 2816, FF = 2816, FF2 = 5632, NMOD = 6144;
constexpr float EPS = 1e-6f;
constexpr float QS = 0.125f * 1.4426950408889634f;
#define LAS __attribute__((address_space(3)))
typedef pg8::bf16_t bf16_t;
typedef pg8::f32x4 f32x4;
typedef pg8::u32x4 u32x4;
typedef unsigned u32x2 __attribute__((ext_vector_type(2)));
using pg8::Unit;

__device__ __forceinline__ unsigned cvt_pk_bf16(float lo, float hi) { unsigned r; asm volatile("v_cvt_pk_bf16_f32 %0, %1, %2" : "=v"(r) : "v"(lo), "v"(hi)); return r; }
__device__ __forceinline__ float bf_lo(unsigned u) { return __uint_as_float(u << 16); }
__device__ __forceinline__ float bf_hi(unsigned u) { return __uint_as_float(u & 0xffff0000u); }
__device__ __forceinline__ float ex2(float x) { return __builtin_amdgcn_exp2f(x); }
__device__ __forceinline__ float lg2(float x) { return __builtin_amdgcn_logf(x); }
__device__ __forceinline__ float rcpf_(float x) { return __builtin_amdgcn_rcpf(x); }
__device__ __forceinline__ float gelu_tanh(float v) { const float u = v + 0.044715f * v * v * v; return v * rcpf_(1.f + ex2(-2.302208199f * u)); }
__device__ __forceinline__ float silu_(float v) { return v * rcpf_(1.f + ex2(-1.4426950409f * v)); }
template <int CTRL> __device__ __forceinline__ float dpp_f(float v) { return __int_as_float(__builtin_amdgcn_update_dpp(0, __float_as_int(v), CTRL, 0xf, 0xf, false)); }
template <int R> __device__ __forceinline__ f32x4 ror4(f32x4 v) { f32x4 r; r[0] = dpp_f<0x120 + R>(v[0]); r[1] = dpp_f<0x120 + R>(v[1]); r[2] = dpp_f<0x120 + R>(v[2]); r[3] = dpp_f<0x120 + R>(v[3]); return r; }

__device__ __forceinline__ float row_rs(const float* ssp, unsigned row) { const f32x4* p = (const f32x4*)((const char*)ssp + row * 64u); const f32x4 a = p[0], b = p[1], c = p[2], d = p[3];
    const f32x4 t = (a + b) + (c + d); return rsqrtf(((t[0] + t[1]) + (t[2] + t[3])) * (1.f / 1024.f) + 1e-6f); }
__device__ __forceinline__ int phys_in(int n0) {
    if (n0 < 512) return n0;
    if (n0 < 1664) return 1280 + (n0 - 512);
    if (n0 < 2432) { const int q = n0 - 1664, hh = q >> 6, half = (q >> 5) & 1; return (2 + (hh >> 2)) * 256 + 128 * half + 32 * (hh & 3); }
    return 1280 + 1152 + (n0 - 2432);
}
__device__ __forceinline__ int phys_up(int n0) { if (n0 < FF) return (n0 >> 7) * 256 + (n0 & 127); const int q = n0 - FF; return (q >> 7) * 256 + 128 + (q & 127); }

constexpr size_t MiB = 1u << 20;
constexpr size_t WS_CTL = 0, WS_MOD = 1 * MiB, WS_SW1 = 2 * MiB, WS_SW2 = 3 * MiB, WS_SS = 4 * MiB, WS_CT = 5 * MiB, WS_ST = 7 * MiB, WS_LSE = 9 * MiB,
                 WS_LASTU = 10 * MiB, WS_FIRSTU = 13 * MiB, WS_YC = 16 * MiB, WS_WIN = 28 * MiB, WS_WOUT = 50 * MiB, WS_WUP = 58 * MiB, WS_WDN = 102 * MiB,
                 WS_HA = 124 * MiB, WS_PROJ = 156 * MiB, WS_YMIX = 244 * MiB, WS_G = 276 * MiB, WS_SSP = 364 * MiB, WS_END = 374 * MiB;
constexpr int RING_BYTES = 131072, HALO_OFF = RING_BYTES, RTAB_OFF = RING_BYTES + 8192, RTAB_UNITS = 16, LDS_BYTES = RTAB_OFF + RTAB_UNITS * 1024;

#define UNPK8(dst, base, v) do { dst[base + 0] = bf_lo(v.x); dst[base + 1] = bf_hi(v.x); dst[base + 2] = bf_lo(v.y); dst[base + 3] = bf_hi(v.y); dst[base + 4] = bf_lo(v.z); dst[base + 5] = bf_hi(v.z); dst[base + 6] = bf_lo(v.w); dst[base + 7] = bf_hi(v.w); } while (0)
struct EpiIn {
    static constexpr bool PERM = true, AFTER_DRAIN = false;
    bf16_t* P; const LAS float* rtab; const float* sw; const float* ct; const float* st;
    __device__ __forceinline__ void operator()(f32x4 (&acc)[2][2][4][2], const Unit& u, int wr, int wc, int fr, int fq, int ui) const {
        { int t_ = threadIdx.x; asm volatile("" : "+v"(t_)); fr = t_ & 15; fq = (t_ >> 4) & 3; }
        const int b = u.pm >> 4; const float* swp = sw + b * INW + u.pn * 256 + wc * 32 + 8 * fq;
        const int row0 = u.pm * 256 + wr * 64 + fr;
        f32x4 sv[2][2];
#pragma unroll
        for (int bj = 0; bj < 2; ++bj)
#pragma unroll
            for (int n = 0; n < 2; ++n) sv[bj][n] = *(const f32x4*)(swp + bj * 128 + 4 * n);
        if (u.pn >= 2 && u.pn <= 4) {
            const int hh = (u.pn - 2) * 4 + wc; const float qs = hh < 6 ? QS : 1.f;
#pragma unroll
            for (int ai = 0; ai < 2; ++ai)
#pragma unroll
                for (int m = 0; m < 4; ++m) { const int row = row0 + ai * 128 + m * 16; const float r = rtab[ui * 256 + (row & 255)];
                    const float* cp = ct + (size_t)row * 32 + 8 * fq; const float* sp = st + (size_t)row * 32 + 8 * fq; u32x4 w1, w2;
#pragma unroll
                    for (int n = 0; n < 2; ++n) { const f32x4 c = *(const f32x4*)(cp + 4 * n), s = *(const f32x4*)(sp + 4 * n);
                        const f32x4 v1 = acc[ai][0][m][n] * r + sv[0][n], v2 = acc[ai][1][m][n] * r + sv[1][n];
                        const f32x4 o1 = (v1 * c - v2 * s) * qs, o2 = (v2 * c + v1 * s) * qs;
                        w1[2 * n] = cvt_pk_bf16(o1[0], o1[1]); w1[2 * n + 1] = cvt_pk_bf16(o1[2], o1[3]); w2[2 * n] = cvt_pk_bf16(o2[0], o2[1]); w2[2 * n + 1] = cvt_pk_bf16(o2[2], o2[3]); }
                    bf16_t* dst = P + (size_t)row * INW + 1664 + hh * 64 + 8 * fq; *(u32x4*)dst = w1; *(u32x4*)(dst + 32) = w2; }
        } else {
            int lc[2]; float sc[2]; const bool gel = u.pn < 2;
#pragma unroll
            for (int bj = 0; bj < 2; ++bj) { if (u.pn < 2) { lc[bj] = u.pn * 256 + bj * 128; sc[bj] = 1.f; }
                else { const int j0 = (u.pn - 5) * 256 + bj * 128; lc[bj] = j0 < 1152 ? 512 + j0 : 2432 + (j0 - 1152); sc[bj] = lc[bj] < 896 ? QS : 1.f; } }
#pragma unroll
            for (int ai = 0; ai < 2; ++ai)
#pragma unroll
                for (int m = 0; m < 4; ++m) { const int row = row0 + ai * 128 + m * 16; const float r = rtab[ui * 256 + (row & 255)];
#pragma unroll
                    for (int bj = 0; bj < 2; ++bj) { f32x4 v0 = acc[ai][bj][m][0] * r + sv[bj][0], v1 = acc[ai][bj][m][1] * r + sv[bj][1];
                        if (gel) {
#pragma unroll
                            for (int e = 0; e < 4; ++e) { v0[e] = gelu_tanh(v0[e]); v1[e] = gelu_tanh(v1[e]); } }
                        else { v0 = v0 * sc[bj]; v1 = v1 * sc[bj]; }
                        u32x4 w; w.x = cvt_pk_bf16(v0[0], v0[1]); w.y = cvt_pk_bf16(v0[2], v0[3]); w.z = cvt_pk_bf16(v1[0], v1[1]); w.w = cvt_pk_bf16(v1[2], v1[3]);
                        *(u32x4*)(P + (size_t)row * INW + lc[bj] + wc * 32 + 8 * fq) = w; } }
        }
    }
};
struct EpiRes {
    static constexpr bool PERM = false, AFTER_DRAIN = false;
    const float* xin; float* xout; const float* gate; float* ssout; const float* gnext; const float* scnext; bf16_t* xs;
    __device__ __forceinline__ void operator()(f32x4 (&acc)[2][2][4][2], const Unit& u, int wr, int wc, int fr, int fq, int ui) const {
        { int t_ = threadIdx.x; asm volatile("" : "+v"(t_)); fr = t_ & 15; fq = (t_ >> 4) & 3; }
        const int b = u.pm >> 4, col0 = u.pn * 256 + wc * 32 + 4 * fq;
        f32x4 gt[2][2], gs[2][2];
#pragma unroll
        for (int bj = 0; bj < 2; ++bj)
#pragma unroll
            for (int n = 0; n < 2; ++n) { const int col = col0 + bj * 128 + n * 16; gt[bj][n] = *(const f32x4*)(gate + b * NMOD + col) + 1.f;
                gs[bj][n] = gnext ? *(const f32x4*)(gnext + col) * (*(const f32x4*)(scnext + b * NMOD + col) + 1.f) : (f32x4){0.f, 0.f, 0.f, 0.f}; }
#pragma unroll
        for (int am = 0; am < 4; ++am) { const int ai = am >> 1, mb = (am & 1) * 2;
            f32x4 pre[2][2][2];
#pragma unroll
            for (int mm = 0; mm < 2; ++mm) { const size_t rb = (size_t)(u.pm * 256 + ai * 128 + wr * 64 + (mb + mm) * 16 + fr) * D + col0;
#pragma unroll
                for (int bj = 0; bj < 2; ++bj)
#pragma unroll
                    for (int n = 0; n < 2; ++n) pre[mm][bj][n] = *(const f32x4*)(xin + rb + bj * 128 + n * 16); }
#pragma unroll
            for (int mm = 0; mm < 2; ++mm) { const int m = mb + mm; const int row = u.pm * 256 + ai * 128 + wr * 64 + m * 16 + fr; float q = 0.f;
#pragma unroll
                for (int bj = 0; bj < 2; ++bj)
#pragma unroll
                    for (int n = 0; n < 2; ++n) { const size_t off = (size_t)row * D + col0 + bj * 128 + n * 16;
                        const f32x4 xn = pre[mm][bj][n] + gt[bj][n] * acc[ai][bj][m][n]; *(f32x4*)(xout + off) = xn;
                        q += (xn[0] * xn[0] + xn[1] * xn[1]) + (xn[2] * xn[2] + xn[3] * xn[3]);
                        if (gnext) { const f32x4 o = xn * gs[bj][n]; u32x2 w; w.x = cvt_pk_bf16(o[0], o[1]); w.y = cvt_pk_bf16(o[2], o[3]); *(u32x2*)(xs + off) = w; } }
                q += __shfl_xor(q, 16); q += __shfl_xor(q, 32);
                if (fq == 0) ssout[(size_t)row * 16 + u.pn * 4 + wc] = q; } }
    }
};
struct EpiU {
    static constexpr bool PERM = true, AFTER_DRAIN = false;
    bf16_t* U; const float* ss; const float* sw; int rowoff;
    __device__ __forceinline__ void operator()(f32x4 (&acc)[2][2][4][2], const Unit& u, int wr, int wc, int fr, int fq, int ui) const {
        { int t_ = threadIdx.x; asm volatile("" : "+v"(t_)); fr = t_ & 15; fq = (t_ >> 4) & 3; }
        const int b = (rowoff >> 12) + (u.pm >> 4), cl = wc * 32 + 8 * fq;
        const unsigned rowl = (unsigned)(u.pm * 256 + wr * 64 + fr);
        f32x4 sv[2][2];
        const char* swb = (const char*)sw + (unsigned)(b * FF2 + u.pn * 256 + cl) * 4u;
#pragma unroll
        for (int bj = 0; bj < 2; ++bj)
#pragma unroll
            for (int n = 0; n < 2; ++n) sv[bj][n] = *(const f32x4*)(swb + (bj * 128 + 4 * n) * 4);
        char* up = (char*)U + (rowl * (unsigned)FF2 + (unsigned)(u.pn * 128 + cl)) * 2u;
#pragma unroll
        for (int ai = 0; ai < 2; ++ai)
#pragma unroll
            for (int m = 0; m < 4; ++m) { const float r = row_rs(ss, (unsigned)rowoff + rowl + ai * 128 + m * 16);
#pragma unroll
                for (int bj = 0; bj < 2; ++bj) { const f32x4 v0 = acc[ai][bj][m][0] * r + sv[bj][0], v1 = acc[ai][bj][m][1] * r + sv[bj][1];
                    u32x4 w; w.x = cvt_pk_bf16(v0[0], v0[1]); w.y = cvt_pk_bf16(v0[2], v0[3]); w.z = cvt_pk_bf16(v1[0], v1[1]); w.w = cvt_pk_bf16(v1[2], v1[3]);
                    *(u32x4*)(up + (unsigned)((ai * 128 + m * 16) * FF2 + bj * FF) * 2u) = w; } }
    }
};
__device__ __forceinline__ u32x4 ld16_agent(const bf16_t* p) { const unsigned long long a = __hip_atomic_load((const unsigned long long*)p, __ATOMIC_RELAXED, __HIP_MEMORY_SCOPE_AGENT), b = __hip_atomic_load((const unsigned long long*)p + 1, __ATOMIC_RELAXED, __HIP_MEMORY_SCOPE_AGENT);
    u32x4 r; r.x = (unsigned)a; r.y = (unsigned)(a >> 32); r.z = (unsigned)b; r.w = (unsigned)(b >> 32); return r; }
struct EpiUc {
    static constexpr bool PERM = true, AFTER_DRAIN = false;
    bf16_t* Gout; const LAS float* rtab; const float* sw; const float* cw; const float* cb; float* lastU; float* firstU; bf16_t* scr2;
    __device__ __forceinline__ void operator()(f32x4 (&acc)[2][2][4][2], const Unit& u, int wr, int wc, int fr, int fq, int ui) const {
        int t_ = threadIdx.x; asm volatile("" : "+v"(t_)); fr = t_ & 15; fq = (t_ >> 4) & 3;
        const int b = u.pm >> 4, cl = wc * 32 + 8 * fq;
        const unsigned rowl = (unsigned)(wr * 64 + fr);
        bf16_t* const scr = scr2 + (size_t)(ui & 1) * 65536;
        { float rr[2][4];
#pragma unroll
          for (int ai = 0; ai < 2; ++ai)
#pragma unroll
              for (int m = 0; m < 4; ++m) rr[ai][m] = rtab[ui * 256 + rowl + ai * 128 + m * 16];
          const unsigned so = (unsigned)(b * FF2 + u.pn * 256 + cl) * 4u;
#pragma unroll
          for (int bj = 0; bj < 2; ++bj) { const f32x4 sv0 = *(const f32x4*)((const char*)sw + (so + (unsigned)(bj * 512))), sv1 = *(const f32x4*)((const char*)sw + (so + (unsigned)(bj * 512 + 16)));
#pragma unroll
              for (int ai = 0; ai < 2; ++ai)
#pragma unroll
                  for (int m = 0; m < 4; ++m) { const f32x4 v0 = acc[ai][bj][m][0] * rr[ai][m] + sv0, v1 = acc[ai][bj][m][1] * rr[ai][m] + sv1;
                      u32x4 w; w.x = cvt_pk_bf16(v0[0], v0[1]); w.y = cvt_pk_bf16(v0[2], v0[3]); w.z = cvt_pk_bf16(v1[0], v1[1]); w.w = cvt_pk_bf16(v1[2], v1[3]);
                      *(u32x4*)((char*)scr + ((rowl + ai * 128 + m * 16) * 256u + (unsigned)(bj * 128 + cl)) * 2u) = w;
                      if (m == 3 && ai == 1 && wr == 1 && fr >= 14) { float* lp = lastU + ((size_t)u.pm * 2 + (fr - 14)) * FF2 + u.pn * 256 + bj * 128 + cl; *(f32x4*)lp = v0; *(f32x4*)(lp + 4) = v1; }
                      if (m == 0 && ai == 0 && wr == 0 && fr < 2) { float* fp = firstU + ((size_t)u.pm * 2 + fr) * FF2 + u.pn * 256 + bj * 128 + cl; *(f32x4*)fp = v0; *(f32x4*)(fp + 4) = v1; } } } }
        asm volatile("s_waitcnt vmcnt(0)" ::: "memory"); __builtin_amdgcn_s_barrier();
        { const int cgp = t_ & 15, r0 = (t_ >> 4) * 8, gcol = u.pn * 128 + cgp * 8;
          float wg[3][8], wv[3][8], bg[8], bv[8];
#pragma unroll
          for (int k = 0; k < 3; ++k)
#pragma unroll
              for (int e = 0; e < 8; e += 4) { const f32x4 a = *(const f32x4*)(cw + k * FF2 + gcol + e), c2 = *(const f32x4*)(cw + k * FF2 + FF + gcol + e);
#pragma unroll
                  for (int q = 0; q < 4; ++q) { wg[k][e + q] = a[q]; wv[k][e + q] = c2[q]; } }
#pragma unroll
          for (int e = 0; e < 8; e += 4) { const f32x4 a = *(const f32x4*)(cb + gcol + e), c2 = *(const f32x4*)(cb + FF + gcol + e);
#pragma unroll
              for (int q = 0; q < 4; ++q) { bg[e + q] = a[q]; bv[e + q] = c2[q]; } }
          float g2[8], g1[8], v2[8], v1_[8];
          const bf16_t* sp = scr + (size_t)r0 * 256 + cgp * 8;
          if (r0 > 0) { const u32x4 a = ld16_agent(sp - 512), c2 = ld16_agent(sp - 512 + 128), d = ld16_agent(sp - 256), e2 = ld16_agent(sp - 256 + 128);
              UNPK8(g2, 0, a); UNPK8(v2, 0, c2); UNPK8(g1, 0, d); UNPK8(v1_, 0, e2); }
          else {
#pragma unroll
              for (int e = 0; e < 8; ++e) { g2[e] = 0.f; g1[e] = 0.f; v2[e] = 0.f; v1_[e] = 0.f; } }
#pragma unroll
          for (int k = 0; k < 8; ++k) { const u32x4 a = ld16_agent(sp + k * 256), c2 = ld16_agent(sp + k * 256 + 128);
              float g0[8], v0[8]; UNPK8(g0, 0, a); UNPK8(v0, 0, c2);
              float res[8];
#pragma unroll
              for (int e = 0; e < 8; ++e) { const float og = bg[e] + wg[0][e] * g2[e] + wg[1][e] * g1[e] + wg[2][e] * g0[e], ov = bv[e] + wv[0][e] * v2[e] + wv[1][e] * v1_[e] + wv[2][e] * v0[e];
                  res[e] = silu_(og) * ov; g2[e] = g1[e]; g1[e] = g0[e]; v2[e] = v1_[e]; v1_[e] = v0[e]; }
              u32x4 w; w.x = cvt_pk_bf16(res[0], res[1]); w.y = cvt_pk_bf16(res[2], res[3]); w.z = cvt_pk_bf16(res[4], res[5]); w.w = cvt_pk_bf16(res[6], res[7]);
              *(u32x4*)(Gout + (size_t)(u.pm * 256 + r0 + k) * FF + gcol) = w; } }
    }
};
struct Args { const float* in[17]; float* out; unsigned char* ws; };

#define XB_TMO      128
#define XB_XCNT(j)  (256  + 64 * (j))
#define XB_XSUB(j)  (1280 + 64 * (j))
#define XB_XGEN(j)  (2304 + 64 * (j))
#define XB_TOP      3328
#define XB_TOPGEN   3392
#define XCD_BAR_WORDS 3456
#define XB_SPIN_CAP (1u << 18)

__device__ __forceinline__ unsigned xb_ld(unsigned* p)              { return __hip_atomic_load(p, __ATOMIC_RELAXED, __HIP_MEMORY_SCOPE_AGENT); }
__device__ __forceinline__ unsigned xb_add(unsigned* p, unsigned v) { return __hip_atomic_fetch_add(p, v, __ATOMIC_RELAXED, __HIP_MEMORY_SCOPE_AGENT); }
__device__ __forceinline__ unsigned xb_xcc_id() { return (unsigned)__builtin_amdgcn_s_getreg((3 << 11) | 20) & 0xFu; }
#define XB_SPIN(cond, bar) do { unsigned _sp = 0; while (cond) { __builtin_amdgcn_s_sleep(1); \
    if ((++_sp & 255u) == 0u) { if (xb_ld(&(bar)[XB_TMO])) break; if (_sp > XB_SPIN_CAP) { atomicAdd(&(bar)[XB_TMO], 1u); break; } } } } while (0)

struct XcdBarrier {
    unsigned* bar; unsigned x;
    volatile LAS unsigned* st;
};

__device__ __forceinline__ XcdBarrier xcd_barrier_post(unsigned* bar, volatile LAS unsigned* st) {
    XcdBarrier b; b.bar = bar; b.x = xb_xcc_id(); b.st = st;
    if (threadIdx.x == 0) (void)xb_add(&bar[XB_XCNT(b.x)], 1u);
    return b;
}
__device__ __forceinline__ void xcd_barrier_complete(unsigned* bar, unsigned x, unsigned& nloc, unsigned& nx) {
    const unsigned G = gridDim.x * gridDim.y * gridDim.z;
    unsigned sum, cnt, mine, sp = 0u;
    for (;;) {
        sum = 0u; cnt = 0u; mine = 0u;
#pragma unroll
        for (unsigned j = 0; j < 16; ++j) { const unsigned c = xb_ld(&bar[XB_XCNT(j)]); sum += c; cnt += (c > 0u) ? 1u : 0u; mine = (j == x) ? c : mine; }
        if (sum == G) break;
        __builtin_amdgcn_s_sleep(1);
        if ((++sp & 255u) == 0u) { if (xb_ld(&bar[XB_TMO])) break; if (sp > XB_SPIN_CAP) { atomicAdd(&bar[XB_TMO], 1u); break; } }
    }
    nloc = mine > 0u ? mine : 1u; nx = cnt > 0u ? cnt : 1u;
}

__device__ __forceinline__ void xcd_barrier(const XcdBarrier& b_in) {
    XcdBarrier b = b_in; b.x = (unsigned)__builtin_amdgcn_readfirstlane((int)xb_xcc_id());
    asm volatile("s_waitcnt vmcnt(0)" ::: "memory");
    __syncthreads();
    if (threadIdx.x == 0) {
        unsigned* bar = b.bar;
        __builtin_amdgcn_s_waitcnt(0);
        unsigned nloc = b.st[0], nx = b.st[1];
        if (nloc == 0u) { xcd_barrier_complete(bar, b.x, nloc, nx); b.st[0] = nloc; b.st[1] = nx; }
        const unsigned old = xb_add(&bar[XB_XSUB(b.x)], 1u);
        const unsigned gen = old / nloc;
        if (old + 1u == (gen + 1u) * nloc) {
            __builtin_amdgcn_fence(__ATOMIC_RELEASE, "agent");
            asm volatile("s_waitcnt vmcnt(0)" ::: "memory");
            const unsigned og = xb_add(&bar[XB_TOP], 1u);
            const unsigned tg = og / nx;
            if (og + 1u == (tg + 1u) * nx) xb_add(&bar[XB_TOPGEN], 1u);
            else XB_SPIN(xb_ld(&bar[XB_TOPGEN]) == tg, bar);
            __builtin_amdgcn_fence(__ATOMIC_ACQUIRE, "agent");
            xb_add(&bar[XB_XGEN(b.x)], 1u);
            asm volatile("s_waitcnt vmcnt(0)" ::: "memory");
        } else {
            XB_SPIN(xb_ld(&bar[XB_XGEN(b.x)]) == gen, bar);
            __builtin_amdgcn_fence(__ATOMIC_ACQUIRE, "agent");
            asm volatile("s_waitcnt vmcnt(0)" ::: "memory");
        }
    }
    __syncthreads();
}

__device__ __forceinline__ void gbar(unsigned* cnt, unsigned& epoch) {
    asm volatile("s_waitcnt vmcnt(0)" ::: "memory");
    __syncthreads();
    epoch += gridDim.x;
    if (threadIdx.x == 0) {
        __builtin_amdgcn_fence(__ATOMIC_RELEASE, "agent");
        asm volatile("s_waitcnt vmcnt(0)" ::: "memory");
        __hip_atomic_fetch_add(cnt, 1u, __ATOMIC_RELAXED, __HIP_MEMORY_SCOPE_AGENT);
        while (__hip_atomic_load(cnt, __ATOMIC_RELAXED, __HIP_MEMORY_SCOPE_AGENT) < epoch) __builtin_amdgcn_s_sleep(1);
        __builtin_amdgcn_fence(__ATOMIC_ACQUIRE, "agent");
        asm volatile("s_waitcnt vmcnt(0)" ::: "memory");
    }
    __syncthreads();
}


template <bool SILU> __device__ __forceinline__ float gemv_item(float* sm, int tid, const float* vsrc, int vstride, const float* W, int N, int j0) {
    const int lane = tid & 63, w = tid >> 6;
    for (int i = tid; i < 4096; i += 512) { const int b = i >> 10, k = i & 1023; const float v = vsrc[(size_t)b * vstride + k]; sm[i] = SILU ? v / (1.f + expf(-v)) : v; }
    __syncthreads();
    float a0 = 0.f, a1 = 0.f, a2 = 0.f, a3 = 0.f;
    const float* wp = W + (size_t)(128 * w) * N + j0 + lane;
#pragma unroll 8
    for (int k = 0; k < 128; ++k) { const float wv = wp[(size_t)k * N]; const int kk = 128 * w + k; a0 += sm[kk] * wv; a1 += sm[1024 + kk] * wv; a2 += sm[2048 + kk] * wv; a3 += sm[3072 + kk] * wv; }
    float* red = sm + 4096;
    red[(w * 4 + 0) * 64 + lane] = a0; red[(w * 4 + 1) * 64 + lane] = a1; red[(w * 4 + 2) * 64 + lane] = a2; red[(w * 4 + 3) * 64 + lane] = a3;
    __syncthreads();
    float s = 0.f;
    if (tid < 256) { const int b = tid >> 6;
#pragma unroll
        for (int ww = 0; ww < 8; ++ww) s += red[(ww * 4 + b) * 64 + lane]; }
    return s;
}
__device__ __forceinline__ void transpose_item(const float* W, int K, int N, bf16_t* WT, int k0, int n0, int prow0, float* scr, int lane) {
#pragma unroll 8
    for (int i = 0; i < 32; ++i) { const int kk = 2 * i + (lane >> 5); scr[kk * 33 + (lane & 31)] = W[(size_t)(k0 + kk) * N + n0 + (lane & 31)]; }
    asm volatile("s_waitcnt lgkmcnt(0)" ::: "memory");
    const int c = lane & 7;
#pragma unroll
    for (int j = 0; j < 4; ++j) { const int n = (lane >> 3) + 8 * j; const float* s = scr + (8 * c) * 33 + n;
        u32x4 o; o.x = cvt_pk_bf16(s[0 * 33], s[1 * 33]); o.y = cvt_pk_bf16(s[2 * 33], s[3 * 33]); o.z = cvt_pk_bf16(s[4 * 33], s[5 * 33]); o.w = cvt_pk_bf16(s[6 * 33], s[7 * 33]);
        *(u32x4*)(WT + (size_t)(prow0 + n) * K + k0 + 8 * c) = o; }
    asm volatile("s_waitcnt lgkmcnt(0)" ::: "memory");
}

__device__ __forceinline__ void mix_a_unit(float* sm, int tid, int unit, const bf16_t* proj, const float* g_sgu, const float* w_sp, const float* b_sp, bf16_t* ymix) {
    float* w = sm; float* vn = sm + 128 * 128;
    const int g = unit & 3, ch = (unit >> 2) & 31, b = unit >> 7; const size_t row0 = (size_t)b * S + ch * 128;
    for (int i = tid; i < 128 * 128; i += 512) { const int t = i >> 7, s = i & 127; w[i] = (s <= t) ? w_sp[(size_t)g * 128 * 128 + i] : 0.f; }
    { const int r = tid >> 2, c0 = (tid & 3) * 16; float v[16]; float ss = 0.f;
      const u32x4* p = (const u32x4*)(proj + (row0 + r) * INW + 256 + g * 64 + c0); const u32x4 v0 = p[0], v1 = p[1];
      UNPK8(v, 0, v0); UNPK8(v, 8, v1);
#pragma unroll
      for (int j = 0; j < 16; ++j) ss += v[j] * v[j];
      ss += __shfl_xor(ss, 1); ss += __shfl_xor(ss, 2);
      const float rr = rsqrtf(ss * (1.f / 64.f) + EPS);
#pragma unroll
      for (int j = 0; j < 16; ++j) vn[r * 64 + c0 + j] = v[j] * rr * g_sgu[g * 64 + c0 + j]; }
    __syncthreads();
    const int tq = tid >> 4, cq = tid & 15;
    float acc[4][4];
#pragma unroll
    for (int i = 0; i < 4; ++i)
#pragma unroll
        for (int j = 0; j < 4; ++j) acc[i][j] = 0.f;
    for (int s = 0; s <= 4 * tq + 3; ++s) { const f32x4 vv = *(const f32x4*)&vn[s * 64 + 4 * cq];
#pragma unroll
        for (int i = 0; i < 4; ++i) { const float wv = w[(4 * tq + i) * 128 + s]; acc[i][0] += wv * vv[0]; acc[i][1] += wv * vv[1]; acc[i][2] += wv * vv[2]; acc[i][3] += wv * vv[3]; } }
#pragma unroll
    for (int i = 0; i < 4; ++i) { const int t = 4 * tq + i; const float bb = b_sp[g * 128 + t];
        const u32x2 uu = *(const u32x2*)(proj + (row0 + t) * INW + g * 64 + 4 * cq);
        u32x2 o; o.x = cvt_pk_bf16(bf_lo(uu.x) * (acc[i][0] + bb), bf_hi(uu.x) * (acc[i][1] + bb)); o.y = cvt_pk_bf16(bf_lo(uu.y) * (acc[i][2] + bb), bf_hi(uu.y) * (acc[i][3] + bb));
        *(u32x2*)(ymix + (row0 + t) * D + g * 64 + 4 * cq) = o; }
    __syncthreads();
}
__device__ __forceinline__ void mix_a_unit_mfma(unsigned char* smb, int tid, int unit, const bf16_t* proj, const float* g_sgu, const float* w_sp, const float* b_sp, bf16_t* ymix) {
    constexpr int VS = 136;
    bf16_t* vnT = (bf16_t*)smb;
    const int g = unit & 3, ch = (unit >> 2) & 31, b = unit >> 7, lane = tid & 63, wv = tid >> 6; const size_t row0 = (size_t)b * S + ch * 128;
    { const int r = tid >> 2, c0 = (tid & 3) * 16; float v[16]; float ss = 0.f;
      const u32x4* p = (const u32x4*)(proj + (row0 + r) * INW + 256 + g * 64 + c0); const u32x4 v0 = p[0], v1 = p[1];
      UNPK8(v, 0, v0); UNPK8(v, 8, v1);
#pragma unroll
      for (int j = 0; j < 16; ++j) ss += v[j] * v[j];
      ss += __shfl_xor(ss, 1); ss += __shfl_xor(ss, 2);
      const float rr = rsqrtf(ss * (1.f / 64.f) + EPS);
#pragma unroll
      for (int j = 0; j < 16; j += 2) { const unsigned pk = cvt_pk_bf16(v[j] * rr * g_sgu[g * 64 + c0 + j], v[j + 1] * rr * g_sgu[g * 64 + c0 + j + 1]);
          vnT[(c0 + j) * VS + r] = (bf16_t)(pk & 0xffffu); vnT[(c0 + j + 1) * VS + r] = (bf16_t)(pk >> 16); } }
    __syncthreads();
    const int tr = lane & 15, quad = lane >> 4, t0 = 16 * wv;
    f32x4 acc[4];
#pragma unroll
    for (int ct = 0; ct < 4; ++ct) acc[ct] = (f32x4){0.f, 0.f, 0.f, 0.f};
    const float* wrow = w_sp + ((size_t)g * 128 + t0 + tr) * 128;
    const int nks = (t0 + 15) / 32 + 1;
    for (int ks = 0; ks < nks; ++ks) { const int s0 = 32 * ks + 8 * quad; const f32x4 a0 = *(const f32x4*)(wrow + s0), a1 = *(const f32x4*)(wrow + s0 + 4);
        float aw[8] = {a0[0], a0[1], a0[2], a0[3], a1[0], a1[1], a1[2], a1[3]};
#pragma unroll
        for (int j = 0; j < 8; ++j) if (s0 + j > t0 + tr) aw[j] = 0.f;
        u32x4 ap; ap.x = cvt_pk_bf16(aw[0], aw[1]); ap.y = cvt_pk_bf16(aw[2], aw[3]); ap.z = cvt_pk_bf16(aw[4], aw[5]); ap.w = cvt_pk_bf16(aw[6], aw[7]);
        const pg8::bf16x8 af = __builtin_bit_cast(pg8::bf16x8, ap);
#pragma unroll
        for (int ct = 0; ct < 4; ++ct) { const pg8::bf16x8 bfr = *(const pg8::bf16x8*)(vnT + (16 * ct + tr) * VS + s0);
            acc[ct] = __builtin_amdgcn_mfma_f32_16x16x32_bf16(af, bfr, acc[ct], 0, 0, 0); } }
#pragma unroll
    for (int j = 0; j < 4; ++j) { const int t = t0 + quad * 4 + j; const float bb = b_sp[g * 128 + t];
#pragma unroll
        for (int ct = 0; ct < 4; ++ct) { const int c = g * 64 + 16 * ct + tr; const float u = bf_lo((unsigned)proj[(row0 + t) * INW + c]);
            const unsigned pk = cvt_pk_bf16(u * (acc[ct][j] + bb), 0.f); ymix[(row0 + t) * D + c] = (bf16_t)(pk & 0xffffu); } }
    __syncthreads();
}
__device__ __forceinline__ void mix_b_naive(int item, int lane, const bf16_t* proj, bf16_t* ymix) {
    const int qb = 63 - item / 24, bh = item % 24, b = bh / 6, h = bh % 6, t = qb * 64 + lane; const size_t rb = (size_t)b * S;
    float q[64], o[64];
    { const u32x4* p = (const u32x4*)(proj + (rb + t) * INW + 512 + h * 64);
#pragma unroll
      for (int c = 0; c < 8; ++c) { const u32x4 v = p[c]; UNPK8(q, 8 * c, v); } }
#pragma unroll
    for (int d = 0; d < 64; ++d) o[d] = 0.f;
    float C = 0.f;
    for (int s = qb * 64 + 62; s >= 0; --s) {
        const u32x4* kp = (const u32x4*)(proj + (rb + s) * INW + 896 + h * 64); const u32x4* vp = (const u32x4*)(proj + (rb + s) * INW + 1280 + h * 64);
        float z = 0.f;
#pragma unroll
        for (int c = 0; c < 8; ++c) { const u32x4 v = kp[c]; float kk[8]; UNPK8(kk, 0, v);
#pragma unroll
            for (int e = 0; e < 8; ++e) z += q[8 * c + e] * kk[e]; }
        float wgt = 0.f;
        if (s < t) { z = fminf(z, 100.f); const float sp = lg2(1.f + ex2(z)); C += sp; wgt = ex2(z - C); }
#pragma unroll
        for (int c = 0; c < 8; ++c) { const u32x4 v = vp[c]; float vv[8]; UNPK8(vv, 0, v);
#pragma unroll
            for (int e = 0; e < 8; ++e) o[8 * c + e] += wgt * vv[e]; }
    }
    u32x4* op = (u32x4*)(ymix + (rb + t) * D + 256 + h * 64);
#pragma unroll
    for (int c = 0; c < 8; ++c) { u32x4 w; w.x = cvt_pk_bf16(o[8 * c], o[8 * c + 1]); w.y = cvt_pk_bf16(o[8 * c + 2], o[8 * c + 3]); w.z = cvt_pk_bf16(o[8 * c + 4], o[8 * c + 5]); w.w = cvt_pk_bf16(o[8 * c + 6], o[8 * c + 7]); op[c] = w; }
}
__device__ __forceinline__ void mix_c_naive(int item, int lane, const bf16_t* proj, bf16_t* ycraw, float* lse) {
    const int h = item % 6, row = (item / 6) * 64 + lane, b = row / S, t = row % S, dil = (h < 2) ? 1 : (h < 4 ? 4 : 16);
    float q[64], o[64];
    { const u32x4* p = (const u32x4*)(proj + (size_t)row * INW + 1664 + h * 64);
#pragma unroll
      for (int c = 0; c < 8; ++c) { const u32x4 v = p[c]; UNPK8(q, 8 * c, v); } }
#pragma unroll
    for (int d = 0; d < 64; ++d) o[d] = 0.f;
    float mx = -INFINITY, l = 0.f;
    for (int m = 0; m <= 128; ++m) { const int idx = t - m * dil; const bool valid = idx >= 0; const int ic = idx < 0 ? 0 : idx;
        const u32x4* kp = (const u32x4*)(proj + ((size_t)b * S + ic) * INW + 2048 + h * 64); const u32x4* vp = (const u32x4*)(proj + ((size_t)b * S + ic) * INW + 2432 + h * 64);
        float z = 0.f;
#pragma unroll
        for (int c = 0; c < 8; ++c) { const u32x4 v = kp[c]; float kk[8]; UNPK8(kk, 0, v);
#pragma unroll
            for (int e = 0; e < 8; ++e) z += q[8 * c + e] * kk[e]; }
        float f = 1.f, p = 0.f;
        if (valid) { const float mn = fmaxf(mx, z); f = ex2(mx - mn); p = ex2(z - mn); mx = mn; }
        l = l * f + p;
#pragma unroll
        for (int c = 0; c < 8; ++c) { const u32x4 v = vp[c]; float vv[8]; UNPK8(vv, 0, v);
#pragma unroll
            for (int e = 0; e < 8; ++e) o[8 * c + e] = o[8 * c + e] * f + p * vv[e]; }
    }
    const float il = 1.f / l;
    u32x4* op = (u32x4*)(ycraw + (size_t)row * 384 + h * 64);
#pragma unroll
    for (int c = 0; c < 8; ++c) { u32x4 w; w.x = cvt_pk_bf16(o[8 * c] * il, o[8 * c + 1] * il); w.y = cvt_pk_bf16(o[8 * c + 2] * il, o[8 * c + 3] * il); w.z = cvt_pk_bf16(o[8 * c + 4] * il, o[8 * c + 5] * il); w.w = cvt_pk_bf16(o[8 * c + 6] * il, o[8 * c + 7] * il); op[c] = w; }
    lse[(size_t)row * 6 + h] = mx + lg2(l);
}
namespace att {
typedef short bf16x8 __attribute__((ext_vector_type(8)));
typedef short s16x4 __attribute__((ext_vector_type(4)));
typedef float f32x16 __attribute__((ext_vector_type(16)));
constexpr int SLOTB = 8192, LDS_K = 0, LDS_V = 3 * SLOTB, LDS_WS = 6 * SLOTB, LDS_OST = LDS_WS + 8 * 64 * 4, LDS_TOT = LDS_OST + 8 * 4096;
__device__ __forceinline__ int crow(int r, int hi) { return (r & 3) + 8 * (r >> 2) + 4 * hi; }
__device__ __forceinline__ void glds16(const void* gsrc, unsigned lds_dst) { unsigned keep;
    asm volatile("s_mov_b32 %0, m0\n\ts_mov_b32 m0, %2\n\ts_nop 0\n\tglobal_load_lds_dwordx4 %1, off\n\ts_mov_b32 m0, %0" : "=&s"(keep) : "v"(gsrc), "s"(lds_dst) : "memory"); }
__device__ __forceinline__ float swapmax(float m) { auto rr = __builtin_amdgcn_permlane32_swap(__float_as_uint(m), __float_as_uint(m), false, false); return fmaxf(__uint_as_float(rr[0]), __uint_as_float(rr[1])); }
__device__ __forceinline__ float swapadd(float m) { auto rr = __builtin_amdgcn_permlane32_swap(__float_as_uint(m), __float_as_uint(m), false, false); return __uint_as_float(rr[0]) + __uint_as_float(rr[1]); }
#define ATT_WAIT_BAR(N) asm volatile("s_waitcnt vmcnt(" #N ") lgkmcnt(0)\n\ts_barrier" ::: "memory")
__device__ __forceinline__ void pv(f32x16* o, int vb, bf16x8 pa0, bf16x8 pa1, bf16x8 pa2, bf16x8 pa3) {
#pragma unroll
    for (int d0 = 0; d0 < 2; ++d0) { s16x4 lo[4], hi[4];
#pragma unroll
        for (int ks = 0; ks < 4; ++ks) {
            asm volatile("ds_read_b64_tr_b16 %0,%1 offset:%c2" : "=&v"(lo[ks]) : "v"(vb), "i"(d0 * 4096 + ks * 1024) : "memory");
            asm volatile("ds_read_b64_tr_b16 %0,%1 offset:%c2" : "=&v"(hi[ks]) : "v"(vb), "i"(d0 * 4096 + ks * 1024 + 512) : "memory"); }
        asm volatile("s_waitcnt lgkmcnt(0)" ::: "memory"); __builtin_amdgcn_sched_barrier(0);
#define ATT_PK(k) (bf16x8){lo[k][0], lo[k][1], lo[k][2], lo[k][3], hi[k][0], hi[k][1], hi[k][2], hi[k][3]}
        o[d0] = __builtin_amdgcn_mfma_f32_32x32x16_bf16(pa0, ATT_PK(0), o[d0], 0, 0, 0);
        o[d0] = __builtin_amdgcn_mfma_f32_32x32x16_bf16(pa1, ATT_PK(1), o[d0], 0, 0, 0);
        o[d0] = __builtin_amdgcn_mfma_f32_32x32x16_bf16(pa2, ATT_PK(2), o[d0], 0, 0, 0);
        o[d0] = __builtin_amdgcn_mfma_f32_32x32x16_bf16(pa3, ATT_PK(3), o[d0], 0, 0, 0);
#undef ATT_PK
    }
}
__device__ __forceinline__ bf16x8 pack8(const f32x16& p, int base) { u32x4 w; w.x = cvt_pk_bf16(p[base], p[base + 1]); w.y = cvt_pk_bf16(p[base + 2], p[base + 3]); w.z = cvt_pk_bf16(p[base + 4], p[base + 5]); w.w = cvt_pk_bf16(p[base + 6], p[base + 7]); return __builtin_bit_cast(bf16x8, w); }

template <int MODE>
__device__ __forceinline__ void unit(LAS unsigned char* shm, const bf16_t* proj, int rowbase, int res, int dil, int q0, int T_lo, int T_hi, int qcol, int kcol, int vcol,
                                     bf16_t* O, int opitch, int ocol, float* lse, int h) {
    int tid_l = threadIdx.x; asm volatile("" : "+v"(tid_l));
    const int tid = tid_l, lane = tid & 63, r32 = lane & 31, hi = lane >> 5; const int wid = __builtin_amdgcn_readfirstlane(tid >> 6);
    const unsigned lds0 = (unsigned)(uintptr_t)shm;
    LAS float* wsf = (LAS float*)(shm + LDS_WS) + wid * 64;
    const size_t tok0 = (size_t)rowbase + res;
    const bf16_t* ksrc = proj + (tok0 + (size_t)dil * lane) * INW + kcol + wid * 8;
    const bf16_t* vsrc = proj + (tok0 + (size_t)dil * (16 * (wid & 3) + (lane >> 2))) * INW + vcol + (wid >> 2) * 32 + (lane & 3) * 8;
    const size_t tstep = (size_t)dil * 64 * INW;
    const unsigned kdst = lds0 + LDS_K + wid * 1024, vdst = lds0 + LDS_V + wid * 1024;
#define ATT_DMA(t, slot) do { glds16(ksrc + (size_t)(t) * tstep, (unsigned)__builtin_amdgcn_readfirstlane(kdst + (slot) * SLOTB)); glds16(vsrc + (size_t)(t) * tstep, (unsigned)__builtin_amdgcn_readfirstlane(vdst + (slot) * SLOTB)); } while (0)
    const int vb0 = (int)(lds0 + LDS_V) + ((lane >> 4) & 1) * 32 + (lane & 3) * 8 + (4 * hi + ((lane & 15) >> 2)) * 64;
    const int qpos = q0 + wid * 32 + r32, qmin = q0 + wid * 32, qmax = qmin + 31;
    const int NT = T_hi - T_lo + 1;
    ATT_DMA(T_hi, 0); if (NT > 1) ATT_DMA(T_hi - 1, 1);
    bf16x8 qr[4];
    { const bf16_t* qp = proj + (tok0 + (size_t)dil * qpos) * INW + qcol + hi * 8;
#pragma unroll
      for (int d0 = 0; d0 < 4; ++d0) qr[d0] = *(const bf16x8*)(qp + d0 * 16); }
    asm volatile("s_waitcnt vmcnt(0)" : "+v"(qr[0]), "+v"(qr[1]), "+v"(qr[2]), "+v"(qr[3]) :: "memory");
    bf16x8 ua0, ua1, ones;
    { u32x4 a, b; unsigned av[8], bv[8];
#pragma unroll
      for (int j = 0; j < 8; ++j) { const int kvk = 8 * (j >> 2) + 4 * hi + (j & 3); av[j] = kvk >= r32 ? 0x3f80u : 0u; bv[j] = kvk + 16 >= r32 ? 0x3f80u : 0u; }
      a.x = av[0] | (av[1] << 16); a.y = av[2] | (av[3] << 16); a.z = av[4] | (av[5] << 16); a.w = av[6] | (av[7] << 16);
      b.x = bv[0] | (bv[1] << 16); b.y = bv[2] | (bv[3] << 16); b.z = bv[4] | (bv[5] << 16); b.w = bv[6] | (bv[7] << 16);
      ua0 = __builtin_bit_cast(bf16x8, a); ua1 = __builtin_bit_cast(bf16x8, b); const u32x4 o1 = {0x3f803f80u, 0x3f803f80u, 0x3f803f80u, 0x3f803f80u}; ones = __builtin_bit_cast(bf16x8, o1); }
    f32x16 o[2]; o[0] = f32x16{}; o[1] = f32x16{};
    float carry = 0.f, mrun = -INFINITY, lrun = 0.f;
    for (int n = 0; n < NT; ++n) { const int kt = T_hi - n; const int slot = n % 3;
        if (n + 1 < NT) ATT_WAIT_BAR(2); else ATT_WAIT_BAR(0);
        if (n + 2 < NT) ATT_DMA(kt - 2, (n + 2) % 3);
        const int kmin = kt * 64, kmax = kmin + 63;
        bool need, full;
        if (MODE == 0) { need = kmin < qmax; full = kmax < qmin; } else { need = (kmin <= qmax) && (kmax >= qmin - 128); full = (kmax <= qmin) && (kmin >= qmax - 128); }
        if (!need) continue;
        f32x16 p0 = f32x16{}, p1 = f32x16{};
        { const LAS unsigned char* kb = shm + LDS_K + slot * SLOTB + hi * 1024 + r32 * 16;
#pragma unroll
          for (int d0 = 0; d0 < 4; ++d0) { const bf16x8 b0 = *(const LAS bf16x8*)(kb + d0 * 2048), b1 = *(const LAS bf16x8*)(kb + d0 * 2048 + 512);
              p0 = __builtin_amdgcn_mfma_f32_32x32x16_bf16(b0, qr[d0], p0, 0, 0, 0); p1 = __builtin_amdgcn_mfma_f32_32x32x16_bf16(b1, qr[d0], p1, 0, 0, 0); } }
        const int kb0 = kmin + 4 * hi;
        if (MODE == 0) {
            f32x16 s0, s1;
#pragma unroll
            for (int r = 0; r < 16; ++r) { const int kv = kb0 + (r & 3) + 8 * (r >> 2);
                p0[r] = fminf(p0[r], 100.f); p1[r] = fminf(p1[r], 100.f);
                float a = lg2(1.f + ex2(p0[r])), b = lg2(1.f + ex2(p1[r]));
                if (!full) { if (kv >= qpos) a = 0.f; if (kv + 32 >= qpos) b = 0.f; }
                s0[r] = a; s1[r] = b; }
            const bf16x8 q0_ = pack8(s0, 0), q1_ = pack8(s0, 8), q2_ = pack8(s1, 0), q3_ = pack8(s1, 8);
            f32x16 c0 = f32x16{}, c1 = f32x16{};
            c0 = __builtin_amdgcn_mfma_f32_32x32x16_bf16(ua0, q0_, c0, 0, 0, 0); c0 = __builtin_amdgcn_mfma_f32_32x32x16_bf16(ua1, q1_, c0, 0, 0, 0);
            c0 = __builtin_amdgcn_mfma_f32_32x32x16_bf16(ones, q2_, c0, 0, 0, 0); c0 = __builtin_amdgcn_mfma_f32_32x32x16_bf16(ones, q3_, c0, 0, 0, 0);
            c1 = __builtin_amdgcn_mfma_f32_32x32x16_bf16(ua0, q2_, c1, 0, 0, 0); c1 = __builtin_amdgcn_mfma_f32_32x32x16_bf16(ua1, q3_, c1, 0, 0, 0);
#pragma unroll
            for (int r = 0; r < 16; ++r) { const int kv = kb0 + (r & 3) + 8 * (r >> 2);
                float a = ex2(p0[r] - c0[r] - carry), b = ex2(p1[r] - c1[r] - carry);
                if (!full) { if (kv >= qpos) a = 0.f; if (kv + 32 >= qpos) b = 0.f; }
                p0[r] = a; p1[r] = b; }
            carry += __shfl(c0[0], r32);
        } else {
            if (!full) {
#pragma unroll
                for (int r = 0; r < 16; ++r) { const int kv = kb0 + (r & 3) + 8 * (r >> 2);
                    if (kv > qpos || kv < qpos - 128) p0[r] = -INFINITY; if (kv + 32 > qpos || kv + 32 < qpos - 128) p1[r] = -INFINITY; } }
            float rm = fmaxf(p0[0], p1[0]);
#pragma unroll
            for (int r = 1; r < 16; ++r) rm = fmaxf(rm, fmaxf(p0[r], p1[r]));
            rm = swapmax(rm);
            const float mnew = fmaxf(mrun, rm), muse = mnew == -INFINITY ? 0.f : mnew, f = ex2(mrun - muse);
            float rs = 0.f;
#pragma unroll
            for (int r = 0; r < 16; ++r) { p0[r] = ex2(p0[r] - muse); p1[r] = ex2(p1[r] - muse); rs += p0[r] + p1[r]; }
            lrun = lrun * f + rs; mrun = mnew;
            if (hi == 0) wsf[r32] = f;
            asm volatile("s_waitcnt lgkmcnt(0)" ::: "memory");
#pragma unroll
            for (int r = 0; r < 16; ++r) { const float fr_ = wsf[crow(r, hi)]; o[0][r] *= fr_; o[1][r] *= fr_; }
        }
        pv(o, vb0 + slot * SLOTB, pack8(p0, 0), pack8(p0, 8), pack8(p1, 0), pack8(p1, 8));
    }
    float rli[16];
    if (MODE == 1) { const float lt = swapadd(lrun); if (hi == 0) { wsf[32 + r32] = lt; lse[(tok0 + (size_t)dil * qpos) * 6 + h] = mrun + lg2(lt); }
        asm volatile("s_waitcnt lgkmcnt(0)" ::: "memory");
#pragma unroll
        for (int r = 0; r < 16; ++r) rli[r] = rcpf_(wsf[32 + crow(r, hi)]); }
    else {
#pragma unroll
        for (int r = 0; r < 16; ++r) rli[r] = 1.f; }
    { LAS bf16_t* stg = (LAS bf16_t*)(shm + LDS_OST) + wid * 2048;
#pragma unroll
      for (int r = 0; r < 16; ++r) { const int orow = crow(r, hi);
#pragma unroll
          for (int d0 = 0; d0 < 2; ++d0) { const unsigned pk = cvt_pk_bf16(o[d0][r] * rli[r], 0.f); stg[orow * 64 + d0 * 32 + r32] = (bf16_t)(pk & 0xffffu); } }
      asm volatile("s_waitcnt lgkmcnt(0)" ::: "memory");
#pragma unroll
      for (int i = 0; i < 4; ++i) { const int row = i * 8 + (lane >> 3), ch = lane & 7; const u32x4 v = *(const LAS u32x4*)(stg + row * 64 + ch * 8);
          *(u32x4*)(O + (tok0 + (size_t)dil * (qmin + row)) * opitch + ocol + ch * 8) = v; } }
    asm volatile("s_waitcnt lgkmcnt(0)\n\ts_barrier" ::: "memory");
#undef ATT_DMA
}
constexpr float SB_TAU = 48.f;
__device__ __forceinline__ void unit_sb(LAS unsigned char* shm, const bf16_t* proj, int rowbase, int q0, int T_hi, int qcol, int kcol, int vcol, bf16_t* O, int opitch, int ocol) {
    int tid_l = threadIdx.x; asm volatile("" : "+v"(tid_l));
    const int tid = tid_l, lane = tid & 63, r32 = lane & 31, hi = lane >> 5; const int wid = __builtin_amdgcn_readfirstlane(tid >> 6);
    const unsigned lds0 = (unsigned)(uintptr_t)shm;
    const size_t tok0 = (size_t)rowbase;
    const bf16_t* ksrc = proj + (tok0 + lane) * INW + kcol + wid * 8;
    const bf16_t* vsrc = proj + (tok0 + (16 * (wid & 3) + (lane >> 2))) * INW + vcol + (wid >> 2) * 32 + (lane & 3) * 8;
    const size_t tstep = (size_t)64 * INW;
    const unsigned kdst = lds0 + LDS_K + wid * 1024, vdst = lds0 + LDS_V + wid * 1024;
    const int NT = T_hi + 1;
#define SB_DMAK(n) do { const int n_ = (n) < NT ? (n) : NT - 1; glds16(ksrc + (size_t)(T_hi - n_) * tstep, (unsigned)__builtin_amdgcn_readfirstlane(kdst + ((n) % 3) * SLOTB)); } while (0)
#define SB_DMAV(n) do { const int n_ = (n) < NT ? (n) : NT - 1; glds16(vsrc + (size_t)(T_hi - n_) * tstep, (unsigned)__builtin_amdgcn_readfirstlane(vdst + ((n) % 3) * SLOTB)); } while (0)
    const int vb0 = (int)(lds0 + LDS_V) + ((lane >> 4) & 1) * 32 + (lane & 3) * 8 + (4 * hi + ((lane & 15) >> 2)) * 64;
    const int qpos = q0 + wid * 32 + r32, qmin = q0 + wid * 32, qmax = qmin + 31;
    SB_DMAK(0); SB_DMAK(1); SB_DMAV(0); SB_DMAK(2); SB_DMAV(1);
    bf16x8 qr[4];
    { const bf16_t* qp = proj + (tok0 + qpos) * INW + qcol + hi * 8;
#pragma unroll
      for (int d0 = 0; d0 < 4; ++d0) qr[d0] = *(const bf16x8*)(qp + d0 * 16); }
    bf16x8 ua0, ua1, ones;
    { u32x4 a, b; unsigned av[8], bv[8];
#pragma unroll
      for (int j = 0; j < 8; ++j) { const int kvk = 8 * (j >> 2) + 4 * hi + (j & 3); av[j] = kvk >= r32 ? 0x3f80u : 0u; bv[j] = kvk + 16 >= r32 ? 0x3f80u : 0u; }
      a.x = av[0] | (av[1] << 16); a.y = av[2] | (av[3] << 16); a.z = av[4] | (av[5] << 16); a.w = av[6] | (av[7] << 16);
      b.x = bv[0] | (bv[1] << 16); b.y = bv[2] | (bv[3] << 16); b.z = bv[4] | (bv[5] << 16); b.w = bv[6] | (bv[7] << 16);
      ua0 = __builtin_bit_cast(bf16x8, a); ua1 = __builtin_bit_cast(bf16x8, b); const u32x4 o1 = {0x3f803f80u, 0x3f803f80u, 0x3f803f80u, 0x3f803f80u}; ones = __builtin_bit_cast(bf16x8, o1); }
    f32x16 o[2]; o[0] = f32x16{}; o[1] = f32x16{};
    float carry = 0.f;
#define SB_STAGE_A(n, d0_, d1_, tot_) do { const int kmin_ = (T_hi - (n)) * 64; const bool full_ = kmin_ + 63 < qmin; const int kb0_ = kmin_ + 4 * hi; \
        f32x16 p0_ = f32x16{}, p1_ = f32x16{}; \
        { const LAS unsigned char* kb_ = shm + LDS_K + ((n) % 3) * SLOTB + hi * 1024 + r32 * 16; \
          _Pragma("unroll") for (int dd = 0; dd < 4; ++dd) { const bf16x8 b0 = *(const LAS bf16x8*)(kb_ + dd * 2048), b1 = *(const LAS bf16x8*)(kb_ + dd * 2048 + 512); \
              p0_ = __builtin_amdgcn_mfma_f32_32x32x16_bf16(b0, qr[dd], p0_, 0, 0, 0); p1_ = __builtin_amdgcn_mfma_f32_32x32x16_bf16(b1, qr[dd], p1_, 0, 0, 0); } } \
        f32x16 s0_, s1_; \
        _Pragma("unroll") for (int r = 0; r < 16; ++r) { const int kv = kb0_ + (r & 3) + 8 * (r >> 2); \
            p0_[r] = fminf(p0_[r], 100.f); p1_[r] = fminf(p1_[r], 100.f); \
            float a_ = lg2(1.f + ex2(p0_[r])), b_ = lg2(1.f + ex2(p1_[r])); \
            if (!full_) { if (kv >= qpos) { a_ = 0.f; p0_[r] = -INFINITY; } if (kv + 32 >= qpos) { b_ = 0.f; p1_[r] = -INFINITY; } } \
            s0_[r] = a_; s1_[r] = b_; } \
        const bf16x8 q0_ = pack8(s0_, 0), q1_ = pack8(s0_, 8), q2_ = pack8(s1_, 0), q3_ = pack8(s1_, 8); \
        f32x16 c0_ = f32x16{}, c1_ = f32x16{}; \
        c0_ = __builtin_amdgcn_mfma_f32_32x32x16_bf16(ua0, q0_, c0_, 0, 0, 0); c1_ = __builtin_amdgcn_mfma_f32_32x32x16_bf16(ua0, q2_, c1_, 0, 0, 0); \
        c0_ = __builtin_amdgcn_mfma_f32_32x32x16_bf16(ua1, q1_, c0_, 0, 0, 0); c1_ = __builtin_amdgcn_mfma_f32_32x32x16_bf16(ua1, q3_, c1_, 0, 0, 0); \
        c0_ = __builtin_amdgcn_mfma_f32_32x32x16_bf16(ones, q2_, c0_, 0, 0, 0); c0_ = __builtin_amdgcn_mfma_f32_32x32x16_bf16(ones, q3_, c0_, 0, 0, 0); \
        _Pragma("unroll") for (int r = 0; r < 16; ++r) { d0_[r] = p0_[r] - c0_[r]; d1_[r] = p1_[r] - c1_[r]; } \
        tot_ = __shfl(c0_[0], r32); } while (0)
    f32x16 dC0 = f32x16{}, dC1 = f32x16{}; float totC = 0.f;
    asm volatile("s_waitcnt vmcnt(0)\n\ts_barrier" : "+v"(qr[0]), "+v"(qr[1]), "+v"(qr[2]), "+v"(qr[3]) :: "memory");
    bool needC = (T_hi * 64) < qmax;
    if (needC) SB_STAGE_A(0, dC0, dC1, totC);
    LAS unsigned* flagp = (LAS unsigned*)(shm + LDS_WS);
    for (int n = 0; n < NT; ++n) {
        ATT_WAIT_BAR(2);
        if (n > 0) { const unsigned f = flagp[(lane & 7) * 64 + 60 + ((n - 1) & 1)]; if (__builtin_amdgcn_ballot_w64(f != 0u) == ~0ull) break; }
        SB_DMAK(n + 3); SB_DMAV(n + 2);
        f32x16 dN0 = f32x16{}, dN1 = f32x16{}; float totN = 0.f;
        const bool needN = (n + 1 < NT) && ((T_hi - (n + 1)) * 64 < qmax);
        if (needN) SB_STAGE_A(n + 1, dN0, dN1, totN);
        if (needC) {
#pragma unroll
            for (int r = 0; r < 16; ++r) { dC0[r] = ex2(dC0[r] - carry); dC1[r] = ex2(dC1[r] - carry); }
            carry += totC;
            pv(o, vb0 + (n % 3) * SLOTB, pack8(dC0, 0), pack8(dC0, 8), pack8(dC1, 0), pack8(dC1, 8));
        }
        { const bool sat = __builtin_amdgcn_ballot_w64(carry >= SB_TAU) == ~0ull; if (lane == 0) flagp[wid * 64 + 60 + (n & 1)] = sat ? 1u : 0u; }
        dC0 = dN0; dC1 = dN1; totC = totN; needC = needN;
    }
    asm volatile("s_waitcnt vmcnt(0)" ::: "memory");
    { LAS bf16_t* stg = (LAS bf16_t*)(shm + LDS_OST) + wid * 2048;
#pragma unroll
      for (int r = 0; r < 16; ++r) { const int orow = crow(r, hi);
#pragma unroll
          for (int d0 = 0; d0 < 2; ++d0) { const unsigned pk = cvt_pk_bf16(o[d0][r], 0.f); stg[orow * 64 + d0 * 32 + r32] = (bf16_t)(pk & 0xffffu); } }
      asm volatile("s_waitcnt lgkmcnt(0)" ::: "memory");
#pragma unroll
      for (int i = 0; i < 4; ++i) { const int row = i * 8 + (lane >> 3), ch = lane & 7; const u32x4 v = *(const LAS u32x4*)(stg + row * 64 + ch * 8);
          *(u32x4*)(O + (tok0 + (qmin + row)) * opitch + ocol + ch * 8) = v; } }
    asm volatile("s_waitcnt lgkmcnt(0)\n\ts_barrier" ::: "memory");
#undef SB_DMAK
#undef SB_DMAV
#undef SB_STAGE_A
}
#undef ATT_WAIT_BAR
}
#define RTAB_BUILD(So_, ssp_) do { int tq_ = threadIdx.x; asm volatile("" : "+v"(tq_)); Unit uq_; \
    for (int i_ = __builtin_amdgcn_readfirstlane(tq_ >> 8); i_ < RTAB_UNITS && (So_).next(i_, uq_); i_ += 2) ((LAS float*)(lds + RTAB_OFF))[i_ * 256 + (tq_ & 255)] = row_rs((ssp_), (unsigned)(uq_.pm * 256 + (tq_ & 255))); \
    __syncthreads(); } while (0)
__global__ void __launch_bounds__(512, 2) fwd_mega(Args a) {
    extern __shared__ __attribute__((aligned(16))) unsigned char lds_raw[];
    LAS unsigned char* lds = (LAS unsigned char*)lds_raw;
    float* smf = (float*)lds_raw;
    cg::grid_group grid = cg::this_grid();
    const int tid = threadIdx.x, lane = tid & 63, wave = __builtin_amdgcn_readfirstlane(tid >> 6);
    const int G = gridDim.x, bid = blockIdx.x, gw = bid * 8 + wave, NGW = G * 8, gt = bid * 512 + tid, NGT = G * 512;
    const float* x = a.in[0]; const float* c = a.in[1]; const int* pos = (const int*)a.in[2]; const float* w_ada = a.in[3]; const float* b_ada = a.in[4];
    const float* g_mix = a.in[5]; const float* w_in = a.in[6]; const float* g_sgu = a.in[7]; const float* w_sp = a.in[8]; const float* b_sp = a.in[9];
    const float* w_out = a.in[10]; const float* g_ffn = a.in[11]; const float* w_up = a.in[12]; const float* conv_w = a.in[13]; const float* conv_b = a.in[14];
    const float* w_down = a.in[15]; const float* g_final = a.in[16];
    float* out = a.out; unsigned char* ws = a.ws;
    unsigned* ctl = (unsigned*)(ws + WS_CTL);
    float* mod = (float*)(ws + WS_MOD); float* sw1 = (float*)(ws + WS_SW1); float* sw2 = (float*)(ws + WS_SW2); float* ssb = (float*)(ws + WS_SSP);
    float* ct = (float*)(ws + WS_CT); float* st = (float*)(ws + WS_ST); float* lse = (float*)(ws + WS_LSE); float* lastU = (float*)(ws + WS_LASTU); float* firstU = (float*)(ws + WS_FIRSTU);
    bf16_t* ycraw = (bf16_t*)(ws + WS_YC); bf16_t* Wt_in = (bf16_t*)(ws + WS_WIN); bf16_t* Wt_out = (bf16_t*)(ws + WS_WOUT); bf16_t* Wt_up = (bf16_t*)(ws + WS_WUP); bf16_t* Wt_dn = (bf16_t*)(ws + WS_WDN);
    bf16_t* hA = (bf16_t*)(ws + WS_HA); bf16_t* proj = (bf16_t*)(ws + WS_PROJ); bf16_t* ymix = (bf16_t*)(ws + WS_YMIX); bf16_t* gbuf = (bf16_t*)(ws + WS_G);

    unsigned* bcnt = (unsigned*)(ws + WS_CTL) + 64; unsigned epoch = 0u;
    { volatile LAS unsigned* stz = (volatile LAS unsigned*)(lds + RING_BYTES + 2048); if (tid < 2) stz[tid] = 0u; __syncthreads(); }
    const XcdBarrier xbar = xcd_barrier_post((unsigned*)(ws + WS_CTL + 8192), (volatile LAS unsigned*)(lds + RING_BYTES + 2048));
    if (bid == 0 && tid < 16) ctl[tid] = 0u;
    for (int i = gt; i < M * 32; i += NGT) { const int r = i >> 5, f = i & 31; const float inv = (float)pow(10000.0, -(double)f / 32.0); const float ang = (float)pos[r] * inv;
        ct[i] = (float)cos((double)ang); st[i] = (float)sin((double)ang); }
    for (int it = bid; it < 4 * 96; it += G) { const int l = it / 96, j0 = (it % 96) * 64;
        const float s = gemv_item<true>(smf, tid, c, D, w_ada + (size_t)l * D * NMOD, NMOD, j0);
        if (tid < 256) { const int b = tid >> 6, j = j0 + (tid & 63); mod[(size_t)(l * 4 + b) * NMOD + j] = s + b_ada[(size_t)l * NMOD + j]; }
        __syncthreads(); }
    { float* scr = smf + wave * 4096;
      for (int it = gw; it < 4 * 6144; it += NGW) { const int l = it / 6144; int r = it % 6144;
          if (r < 1408) { const int kb = r / 88, nb = r % 88; transpose_item(w_in + (size_t)l * D * INW, D, INW, Wt_in + (size_t)l * INW * D, kb * 64, nb * 32, phys_in(nb * 32), scr, lane); continue; } r -= 1408;
          if (r < 512) { const int kb = r / 32, nb = r % 32; transpose_item(w_out + (size_t)l * D * D, D, D, Wt_out + (size_t)l * D * D, kb * 64, nb * 32, nb * 32, scr, lane); continue; } r -= 512;
          if (r < 2816) { const int kb = r / 176, nb = r % 176; transpose_item(w_up + (size_t)l * D * FF2, D, FF2, Wt_up + (size_t)l * FF2 * D, kb * 64, nb * 32, phys_up(nb * 32), scr, lane); continue; } r -= 2816;
          { const int kb = r / 32, nb = r % 32; transpose_item(w_down + (size_t)l * FF * D, FF, D, Wt_dn + (size_t)l * D * FF, kb * 64, nb * 32, nb * 32, scr, lane); } } }
    grid.sync();
    for (int it = bid; it < 4 * 132; it += G) { const int l = it / 132; int r = it % 132;
        if (r < 44) { const int j0 = r * 64; const float s = gemv_item<false>(smf, tid, mod + (size_t)l * 4 * NMOD, NMOD, w_in + (size_t)l * D * INW, INW, j0);
            if (tid < 256) { const int b = tid >> 6, j = j0 + (tid & 63); sw1[(size_t)(l * 4 + b) * INW + phys_in(j & ~31) + (j & 31)] = s; } }
        else { r -= 44; const int j0 = r * 64; const float s = gemv_item<false>(smf, tid, mod + (size_t)l * 4 * NMOD + 3 * D, NMOD, w_up + (size_t)l * D * FF2, FF2, j0);
            if (tid < 256) { const int b = tid >> 6, j = j0 + (tid & 63); sw2[(size_t)(l * 4 + b) * FF2 + phys_up(j & ~31) + (j & 31)] = s; } }
        __syncthreads(); }
    for (int row = gw; row < M; row += NGW) { const int b = row / S; const f32x4* xr = (const f32x4*)(x + (size_t)row * D) + lane; float s2 = 0.f;
#pragma unroll
        for (int j = 0; j < 4; ++j) { const f32x4 v = xr[64 * j]; const int col = 4 * (lane + 64 * j); s2 += (v[0] * v[0] + v[1] * v[1]) + (v[2] * v[2] + v[3] * v[3]);
            const f32x4 gs = *(const f32x4*)(g_mix + col) * (*(const f32x4*)(mod + (size_t)b * NMOD + D + col) + 1.f); const f32x4 o = v * gs;
            u32x2 w; w.x = cvt_pk_bf16(o[0], o[1]); w.y = cvt_pk_bf16(o[2], o[3]); *(u32x2*)(hA + (size_t)row * D + col) = w; }
#pragma unroll
        for (int o = 1; o < 64; o <<= 1) s2 += __shfl_xor(s2, o);
        if (lane < 16) ssb[(size_t)row * 16 + lane] = lane == 0 ? s2 : 0.f; }
    xcd_barrier(xbar);

    for (int l = 0; l < DEPTH; ++l) {
        const float* modl = mod + (size_t)l * 4 * NMOD;
        { pg8::Gemm g{hA, Wt_in + (size_t)l * INW * D, M, INW, D}; pg8::StaticOrder So; So.init(M, INW, G, bid);
          RTAB_BUILD(So, ssb + (size_t)(2 * l) * M * 16);
          EpiIn E{proj, (const LAS float*)(lds + RTAB_OFF), sw1 + (size_t)l * 4 * INW, ct, st};
          pg8::gemm_phase<EpiIn, pg8::StaticOrder, true, true>(lds, g, So, E); }
        xcd_barrier(xbar);
        { int tp = threadIdx.x; asm volatile("" : "+v"(tp));
          volatile unsigned* slot = (volatile unsigned*)(lds_raw + RING_BYTES + 1024);
          if (tp == 0) *slot = atomicAdd(ctl + l, 1u);
          __syncthreads();
          int idx = (int)*slot;
          __syncthreads();
          while (idx < 1280) {
              unsigned nxt = 0u; if (tp == 0) nxt = atomicAdd(ctl + l, 1u);
              if (idx < 384) { const int qb = 15 - idx / 24, bh = idx % 24, b = bh / 6, h = bh % 6;
                  att::unit_sb(lds, proj, b * S, qb * 256, 4 * qb + 3, 512 + h * 64, 896 + h * 64, 1280 + h * 64, ymix, D, 256 + h * 64); }
              else if (idx < 768) { const int j = idx - 384, bh = j % 24, b = bh / 6, h = bh % 6, uidx = j / 24, dil = h < 2 ? 1 : (h < 4 ? 4 : 16), nq = (S / dil) / 256, res = uidx / nq, qb = uidx % nq;
                  att::unit<1>(lds, proj, b * S, res, dil, qb * 256, 4 * qb - 2 < 0 ? 0 : 4 * qb - 2, 4 * qb + 3, 1664 + h * 64, 2048 + h * 64, 2432 + h * 64, ycraw, 384, h * 64, lse, h); }
              else mix_a_unit_mfma(lds_raw, tp, idx - 768, proj, g_sgu + l * 256, w_sp + (size_t)l * 4 * 128 * 128, b_sp + l * 4 * 128, ymix);
              if (tp == 0) *slot = nxt;
              __syncthreads();
              idx = (int)*slot;
              __syncthreads();
          } }
        xcd_barrier(xbar);
        { int tp = threadIdx.x; asm volatile("" : "+v"(tp)); const int lanep = tp & 63, gwp = bid * 8 + (tp >> 6);
          if (lanep < 48) { const int h = lanep >> 3, jj = h & 1;
              for (int row0 = gwp; row0 < M; row0 += 4 * NGW) {
                  float l0[4], l1[4], l2[4]; u32x4 v[4];
#pragma unroll
                  for (int k = 0; k < 4; ++k) { const int row = row0 + k * NGW; if (row < M) { l0[k] = lse[(size_t)row * 6 + jj]; l1[k] = lse[(size_t)row * 6 + 2 + jj]; l2[k] = lse[(size_t)row * 6 + 4 + jj]; v[k] = *(const u32x4*)(ycraw + (size_t)row * 384 + lanep * 8); } }
#pragma unroll
                  for (int k = 0; k < 4; ++k) { const int row = row0 + k * NGW; if (row < M) {
                      const float mm = fmaxf(l0[k], fmaxf(l1[k], l2[k])), e0 = ex2(l0[k] - mm), e1 = ex2(l1[k] - mm), e2 = ex2(l2[k] - mm); const float al = ((h >> 1) == 0 ? e0 : ((h >> 1) == 1 ? e1 : e2)) / (e0 + e1 + e2); u32x4 w;
                      w.x = cvt_pk_bf16(bf_lo(v[k].x) * al, bf_hi(v[k].x) * al); w.y = cvt_pk_bf16(bf_lo(v[k].y) * al, bf_hi(v[k].y) * al); w.z = cvt_pk_bf16(bf_lo(v[k].z) * al, bf_hi(v[k].z) * al); w.w = cvt_pk_bf16(bf_lo(v[k].w) * al, bf_hi(v[k].w) * al);
                      *(u32x4*)(ymix + (size_t)row * D + 640 + lanep * 8) = w; } } } } }
        xcd_barrier(xbar);
        { pg8::StaticOrder So; So.init(M, D, G, bid);
          pg8::Gemm g{ymix, Wt_out + (size_t)l * D * D, M, D, D};
          EpiRes E{l == 0 ? x : out, out, modl + 2 * D, ssb + (size_t)(2 * l + 1) * M * 16, g_ffn + l * D, modl + 4 * D, hA};
          pg8::gemm_phase<EpiRes, pg8::StaticOrder, true, true>(lds, g, So, E); }
        xcd_barrier(xbar);
        { pg8::Gemm g{hA, Wt_up + (size_t)l * FF2 * D, M, FF2, D}; pg8::StaticOrder So; So.init(M, FF2, G, bid);
          RTAB_BUILD(So, ssb + (size_t)(2 * l + 1) * M * 16);
          EpiUc E{gbuf, (const LAS float*)(lds + RTAB_OFF), sw2 + (size_t)l * 4 * FF2, conv_w + (size_t)l * 3 * FF2, conv_b + (size_t)l * FF2, lastU, firstU, proj + (size_t)bid * 131072};
          pg8::gemm_phase<EpiUc, pg8::StaticOrder, true, true>(lds, g, So, E); }
        xcd_barrier(xbar);
        { pg8::StaticOrder So; So.init(M, D, G, bid); Unit u;
          const float* cw = conv_w + (size_t)l * 3 * FF2; const float* cb = conv_b + (size_t)l * FF2;
          int tp = threadIdx.x; asm volatile("" : "+v"(tp));
          for (int i = 0; So.next(i, u); ++i) { if ((u.pm & 15) == 0) continue;
              for (int q = tp; q < FF / 4; q += 512) { const int n = q * 4, pc = (n >> 7) * 256 + (n & 127);
                  const float* f0 = firstU + ((size_t)u.pm * 2) * FF2 + pc; const float* l0 = lastU + ((size_t)(u.pm - 1) * 2) * FF2 + pc;
                  const f32x4 lg0 = *(const f32x4*)l0, lg1 = *(const f32x4*)(l0 + FF2), fg0 = *(const f32x4*)f0, fg1 = *(const f32x4*)(f0 + FF2);
                  const f32x4 lv0 = *(const f32x4*)(l0 + 128), lv1 = *(const f32x4*)(l0 + FF2 + 128), fv0 = *(const f32x4*)(f0 + 128), fv1 = *(const f32x4*)(f0 + FF2 + 128);
                  const f32x4 wg0 = *(const f32x4*)(cw + n), wg1 = *(const f32x4*)(cw + FF2 + n), wg2 = *(const f32x4*)(cw + 2 * FF2 + n), bg = *(const f32x4*)(cb + n);
                  const f32x4 wv0 = *(const f32x4*)(cw + FF + n), wv1 = *(const f32x4*)(cw + FF2 + FF + n), wv2 = *(const f32x4*)(cw + 2 * FF2 + FF + n), bv = *(const f32x4*)(cb + FF + n);
                  const f32x4 og0 = bg + wg0 * lg0 + wg1 * lg1 + wg2 * fg0, ov0 = bv + wv0 * lv0 + wv1 * lv1 + wv2 * fv0;
                  const f32x4 og1 = bg + wg0 * lg1 + wg1 * fg0 + wg2 * fg1, ov1 = bv + wv0 * lv1 + wv1 * fv0 + wv2 * fv1;
                  u32x2 w0_, w1_;
                  w0_.x = cvt_pk_bf16(silu_(og0[0]) * ov0[0], silu_(og0[1]) * ov0[1]); w0_.y = cvt_pk_bf16(silu_(og0[2]) * ov0[2], silu_(og0[3]) * ov0[3]);
                  w1_.x = cvt_pk_bf16(silu_(og1[0]) * ov1[0], silu_(og1[1]) * ov1[1]); w1_.y = cvt_pk_bf16(silu_(og1[2]) * ov1[2], silu_(og1[3]) * ov1[3]);
                  *(u32x2*)(gbuf + (size_t)(u.pm * 256) * FF + n) = w0_; *(u32x2*)(gbuf + (size_t)(u.pm * 256 + 1) * FF + n) = w1_; } }
          asm volatile("s_waitcnt vmcnt(0)" ::: "memory"); __syncthreads();
          pg8::Gemm g{gbuf, Wt_dn + (size_t)l * D * FF, M, D, FF};
          EpiRes E{out, out, modl + 5 * D, ssb + (size_t)(2 * l + 2) * M * 16, l + 1 < DEPTH ? g_mix + (l + 1) * D : nullptr, mod + (size_t)(l + 1 < DEPTH ? l + 1 : l) * 4 * NMOD + D, hA};
          pg8::gemm_phase<EpiRes, pg8::StaticOrder, true, true>(lds, g, So, E); }
        xcd_barrier(xbar);
    }
    int tf = threadIdx.x; asm volatile("" : "+v"(tf)); const int lanef = tf & 63, gwf = bid * 8 + (tf >> 6);
    for (int row = gwf; row < M; row += NGW) { const float r = row_rs(ssb + (size_t)8 * M * 16, (unsigned)row); f32x4* xr = (f32x4*)(out + (size_t)row * D) + lanef;
#pragma unroll
        for (int j = 0; j < 4; ++j) { const int col = 4 * (lanef + 64 * j); xr[64 * j] = xr[64 * j] * r * *(const f32x4*)(g_final + col); } }
}

extern "C" void kernel_launch(void* const* d_in, const int* in_sizes, int n_in, void* d_out, int out_size, void* d_ws, size_t ws_size, hipStream_t stream) {
    static int grid = 0;
    if (grid == 0) {
        if (n_in != 17 || out_size != M * D || ws_size < WS_END) { fprintf(stderr, "kernel_launch: unexpected shapes (n_in %d out %d ws %zu)\n", n_in, out_size, ws_size); grid = -1; return; }
        int dev = 0, cus = 0, per_cu = 0;
        hipGetDevice(&dev); hipDeviceGetAttribute(&cus, hipDeviceAttributeMultiprocessorCount, dev);
        hipFuncSetAttribute((const void*)fwd_mega, hipFuncAttributeMaxDynamicSharedMemorySize, LDS_BYTES);
        hipOccupancyMaxActiveBlocksPerMultiprocessor(&per_cu, (const void*)fwd_mega, 512, LDS_BYTES);
        if (per_cu < 1) per_cu = 1;
        grid = cus * per_cu;
    }
    if (grid < 0) return;
    hipMemsetAsync((char*)d_ws + WS_CTL, 0, 32768, stream);
    Args a{};
    for (int i = 0; i < 17; ++i) a.in[i] = (const float*)d_in[i];
    a.out = (float*)d_out; a.ws = (unsigned char*)d_ws;
    void* args[] = {&a};
    hipError_t e = hipLaunchCooperativeKernel((const void*)fwd_mega, dim3(grid), dim3(512), args, LDS_BYTES, stream);
    if (e != hipSuccess) fprintf(stderr, "cooperative launch failed: %s (grid %d)\n", hipGetErrorString(e), grid);
}
```

```cpp
#include <hip/hip_runtime.h>
#include <hip/hip_cooperative_groups.h>
#include <cstdio>
#include <cstdint>
#include <cmath>
namespace cg = cooperative_groups;
namespace pg8 {
#define PG8_LAS __attribute__((address_space(3)))
typedef unsigned short bf16_t;
typedef short bf16x8 __attribute__((ext_vector_type(8)));
typedef float f32x4 __attribute__((ext_vector_type(4)));
typedef unsigned u32x4 __attribute__((ext_vector_type(4)));
constexpr int BM = 256, BK = 64, HALF = 128, HTB = HALF * BK * 2  , STAGE_BYTES = 8 * HTB, NXCD = 8, WGM = 8;

__host__ __device__ __forceinline__ int lds_byte(int r, int c) { const int st = (r >> 4) * 2 + (c >> 5), rr = r & 15, cc = c & 31, ob = rr * 64 + cc * 2; return st * 1024 + (ob ^ (((ob >> 9) & 1) << 5)); }
__host__ __device__ __forceinline__ void stage_rc(int b, int& R, int& C) { const int st = b / 1024, sb = b % 1024, swz = sb ^ (((sb >> 9) & 1) << 5); R = (st >> 1) * 16 + swz / 64; C = (st & 1) * 32 + (swz % 64) / 2; }
__host__ __device__ __forceinline__ int perm32(int rho) { const int n = rho >> 4, i = rho & 15; return 8 * (i >> 2) + 4 * n + (i & 3); }

struct Unit { int pm, pn; };
struct Gemm { const bf16_t* A; const bf16_t* Bt; int M, N, K; };

struct StaticOrder {
    int nM, nN, nwg, G, c;
    __host__ __device__ void init(int M, int N, int G_, int c_) { nM = M / BM; nN = N / BM; nwg = nM * nN; G = G_; c = c_; }
    __host__ __device__ bool next(int i, Unit& u) const {
        const long L = (long)i * G + c; if (L >= nwg) return false;
        int wgid = (int)L; { const int q = nwg / NXCD, r = nwg % NXCD, xcd = wgid % NXCD, off = wgid / NXCD; wgid = (xcd < r ? xcd * (q + 1) : r * (q + 1) + (xcd - r) * q) + off; }
        const int nig = WGM * nN, gid = wgid / nig, fm = gid * WGM, gsz = (nM - fm) < WGM ? (nM - fm) : WGM;
        u.pm = fm + ((wgid % nig) % gsz); u.pn = (wgid % nig) / gsz; return true;
    }
    __device__ __forceinline__ void a_ready(const Unit&) const {}
    __device__ __forceinline__ void done(const Unit&) const {}
};

template <class Epi, class Sched, bool ALIGN_EPI = false, bool SP2 = false>
__device__ __forceinline__ void gemm_phase(PG8_LAS unsigned char* lds, const Gemm g, const Sched& S, const Epi& E) {
    int tid_l = threadIdx.x; asm volatile("" : "+v"(tid_l));
    const int tid = tid_l, wid = __builtin_amdgcn_readfirstlane(tid >> 6), lane = tid & 63, wr = wid >> 2, wc = wid & 3, fr = lane & 15, fq = lane >> 4;
    const int K = g.K, nt = K / BK;
    unsigned voffA[2], voffB[2];
#pragma unroll
    for (int i = 0; i < 2; ++i) { int R, C; stage_rc(tid * 16 + i * 8192, R, C); const int Rb = Epi::PERM ? ((R & ~31) + perm32(R & 31)) : R;
        voffA[i] = (unsigned)(R * K + C) * 2u; voffB[i] = (unsigned)(Rb * K + C) * 2u; }
    const size_t kstep = (size_t)(BK * 2);
    const size_t hstep = (size_t)HALF * K * 2;
    const size_t tstep = 2 * hstep;
    const unsigned ldsw = (unsigned)wid * 1024u;
    const int aoff = lds_byte(wr * 64 + fr, fq * 8), boff = lds_byte(wc * 32 + fr, fq * 8);
#define PG8_SA(b, h) (((b) * 2 + (h)) * HTB)
#define PG8_SB(b, h) ((4 + (b) * 2 + (h)) * HTB)
#define PG8_STAGE(bufoff, gbase, voff) do { _Pragma("unroll") for (int _i = 0; _i < 2; ++_i) \
        __builtin_amdgcn_global_load_lds((const unsigned*)((const char*)(gbase) + (voff)[_i]), (PG8_LAS unsigned*)(lds + (bufoff) + ldsw + _i * 8192), 16, 0, 0); } while (0)
#define PG8_LDA(dst, b, h) do { _Pragma("unroll") for (int m = 0; m < 4; ++m) _Pragma("unroll") for (int k = 0; k < 2; ++k) dst[m][k] = *(const PG8_LAS bf16x8*)(lds + PG8_SA(b, h) + aoff + m * 2048 + k * 1024); } while (0)
#define PG8_LDB(dst, b, h) do { _Pragma("unroll") for (int n = 0; n < 2; ++n) _Pragma("unroll") for (int k = 0; k < 2; ++k) dst[n][k] = *(const PG8_LAS bf16x8*)(lds + PG8_SB(b, h) + boff + n * 2048 + k * 1024); } while (0)
#define PG8_MMA(ai, bj, At, Bt) do { __builtin_amdgcn_s_setprio(1); _Pragma("unroll") for (int m = 0; m < 4; ++m) _Pragma("unroll") for (int n = 0; n < 2; ++n) _Pragma("unroll") for (int k = 0; k < 2; ++k) \
        acc[ai][bj][m][n] = __builtin_amdgcn_mfma_f32_16x16x32_bf16(Bt[n][k], At[m][k], acc[ai][bj][m][n], 0, 0, 0); __builtin_amdgcn_s_setprio(0); } while (0)
#define PG8_WAIT_V(n) asm volatile("s_waitcnt vmcnt(" #n ")" ::: "memory")
#define PG8_WAIT_L(n) asm volatile("s_waitcnt lgkmcnt(" #n ")" ::: "memory")
#define PG8_BAR __builtin_amdgcn_s_barrier()
#define PG8_SCHED __builtin_amdgcn_sched_barrier(0)
    Unit cur, nxt; int ui = 0;
    if (!S.next(0, cur)) return;
    f32x4 acc[2][2][4][2];
#pragma unroll
    for (int a = 0; a < 2; ++a)
#pragma unroll
        for (int b = 0; b < 2; ++b)
#pragma unroll
            for (int m = 0; m < 4; ++m)
#pragma unroll
                for (int n = 0; n < 2; ++n) acc[a][b][m][n] = (f32x4){0.f, 0.f, 0.f, 0.f};
    bf16x8 At[4][2], B0[2][2], B1[2][2];
    const char* cA = (const char*)g.A + (size_t)cur.pm * tstep; const char* cB = (const char*)g.Bt + (size_t)cur.pn * tstep;
    S.a_ready(cur);
    if constexpr (SP2) {
        PG8_STAGE(PG8_SB(0, 0), cB, voffB); PG8_STAGE(PG8_SB(0, 1), cB + hstep, voffB); PG8_STAGE(PG8_SA(0, 0), cA, voffA); PG8_STAGE(PG8_SA(0, 1), cA + hstep, voffA);
        if (wr == 1) PG8_BAR;
        PG8_WAIT_V(2); PG8_BAR;
        PG8_STAGE(PG8_SB(1, 0), cB + kstep, voffB); PG8_STAGE(PG8_SA(1, 0), cA + kstep, voffA); PG8_STAGE(PG8_SB(1, 1), cB + hstep + kstep, voffB);
        PG8_WAIT_V(6); PG8_BAR;
    } else {
        PG8_STAGE(PG8_SB(0, 0), cB, voffB); PG8_STAGE(PG8_SA(0, 0), cA, voffA); PG8_STAGE(PG8_SB(0, 1), cB + hstep, voffB); PG8_STAGE(PG8_SA(0, 1), cA + hstep, voffA);
        if (wr == 1) PG8_BAR;
        PG8_WAIT_V(4); PG8_BAR;
        PG8_STAGE(PG8_SB(1, 0), cB + kstep, voffB); PG8_STAGE(PG8_SA(1, 0), cA + kstep, voffA); PG8_STAGE(PG8_SB(1, 1), cB + hstep + kstep, voffB);
        PG8_WAIT_V(6); PG8_BAR;
    }
    for (;;) {
        const bool has_next = S.next(ui + 1, nxt);
        const char* nA = has_next ? (const char*)g.A + (size_t)nxt.pm * tstep : cA; const char* nB = has_next ? (const char*)g.Bt + (size_t)nxt.pn * tstep : cB;
        for (int t = 0; t < nt; t += 2) {
            const bool last = (t == nt - 2);
            const char* a1 = cA + (size_t)(t + 1) * kstep;
            const char* a2 = last ? nA : cA + (size_t)(t + 2) * kstep; const char* b2 = last ? nB : cB + (size_t)(t + 2) * kstep;
            const char* a3 = a2 + kstep; const char* b3 = b2 + kstep;
            if (last && has_next) S.a_ready(nxt);
            if constexpr (SP2) {
            PG8_LDB(B0, 0, 0); PG8_LDB(B1, 0, 1); PG8_SCHED; PG8_LDA(At, 0, 0); PG8_STAGE(PG8_SA(1, 1), a1 + hstep, voffA);
            PG8_WAIT_V(8); PG8_WAIT_L(0); PG8_BAR; PG8_MMA(0, 0, At, B0); PG8_MMA(0, 1, At, B1); PG8_BAR; PG8_SCHED;
            PG8_LDA(At, 0, 1); PG8_STAGE(PG8_SB(0, 0), b2, voffB); PG8_STAGE(PG8_SB(0, 1), b2 + hstep, voffB); PG8_STAGE(PG8_SA(0, 0), a2, voffA);
            PG8_WAIT_V(8); PG8_WAIT_L(0); PG8_BAR; PG8_MMA(1, 0, At, B0); PG8_MMA(1, 1, At, B1); PG8_BAR; PG8_SCHED;
            PG8_LDB(B0, 1, 0); PG8_LDB(B1, 1, 1); PG8_SCHED; PG8_LDA(At, 1, 0); PG8_STAGE(PG8_SA(0, 1), a2 + hstep, voffA);
            PG8_WAIT_V(8); PG8_WAIT_L(0); PG8_BAR; PG8_MMA(0, 0, At, B0); PG8_MMA(0, 1, At, B1); PG8_BAR; PG8_SCHED;
            PG8_LDA(At, 1, 1); PG8_STAGE(PG8_SB(1, 0), b3, voffB); PG8_STAGE(PG8_SB(1, 1), b3 + hstep, voffB); PG8_STAGE(PG8_SA(1, 0), a3, voffA);
            PG8_WAIT_V(8); PG8_WAIT_L(0); PG8_BAR; PG8_MMA(1, 0, At, B0); PG8_MMA(1, 1, At, B1); PG8_BAR; PG8_SCHED;
            } else {
            PG8_LDB(B0, 0, 0); PG8_SCHED; PG8_LDA(At, 0, 0); PG8_STAGE(PG8_SA(1, 1), a1 + hstep, voffA);
            PG8_WAIT_L(8); PG8_BAR; PG8_WAIT_L(0); PG8_MMA(0, 0, At, B0); PG8_BAR; PG8_SCHED;
            PG8_LDB(B1, 0, 1); PG8_STAGE(PG8_SB(0, 0), b2, voffB);
            PG8_BAR; PG8_WAIT_L(0); PG8_MMA(0, 1, At, B1); PG8_BAR;
            PG8_LDA(At, 0, 1); PG8_STAGE(PG8_SA(0, 0), a2, voffA);
            PG8_BAR; PG8_WAIT_L(0); PG8_MMA(1, 0, At, B0); PG8_BAR; PG8_SCHED;
            PG8_STAGE(PG8_SB(0, 1), b2 + hstep, voffB);
            PG8_WAIT_V(6); PG8_BAR; PG8_MMA(1, 1, At, B1); PG8_BAR;
            PG8_LDB(B0, 1, 0); PG8_SCHED; PG8_LDA(At, 1, 0); PG8_STAGE(PG8_SA(0, 1), a2 + hstep, voffA);
            PG8_WAIT_L(8); PG8_BAR; PG8_WAIT_L(0); PG8_MMA(0, 0, At, B0); PG8_BAR; PG8_SCHED;
            PG8_LDB(B1, 1, 1); PG8_STAGE(PG8_SB(1, 0), b3, voffB);
            PG8_BAR; PG8_WAIT_L(0); PG8_MMA(0, 1, At, B1); PG8_BAR;
            PG8_LDA(At, 1, 1); PG8_STAGE(PG8_SA(1, 0), a3, voffA);
            PG8_BAR; PG8_WAIT_L(0); PG8_MMA(1, 0, At, B0); PG8_BAR; PG8_SCHED;
            PG8_STAGE(PG8_SB(1, 1), b3 + hstep, voffB);
            PG8_WAIT_V(6); PG8_BAR; PG8_MMA(1, 1, At, B1); PG8_BAR;
            }
        }
        if constexpr (ALIGN_EPI) { if (wr == 0) PG8_BAR; }
        if constexpr (!Epi::AFTER_DRAIN) { E(acc, cur, wr, wc, fr, fq, ui); S.done(cur); }
        if (!has_next) break;
#pragma unroll
        for (int a = 0; a < 2; ++a)
#pragma unroll
            for (int b = 0; b < 2; ++b)
#pragma unroll
                for (int m = 0; m < 4; ++m)
#pragma unroll
                    for (int n = 0; n < 2; ++n) acc[a][b][m][n] = (f32x4){0.f, 0.f, 0.f, 0.f};
        cur = nxt; cA = nA; cB = nB; ++ui;
        if constexpr (ALIGN_EPI) { if (wr == 1) PG8_BAR; }
    }
    PG8_WAIT_V(0);
    if constexpr (!ALIGN_EPI) { if (wr == 0) PG8_BAR; }
    PG8_BAR;
    if constexpr (Epi::AFTER_DRAIN) { E.fused(acc, cur, wr, wc, fr, fq, lds, wid, lane); S.done(cur); }
#undef PG8_SA
#undef PG8_SB
#undef PG8_STAGE
#undef PG8_LDA
#undef PG8_LDB
#undef PG8_MMA
#undef PG8_WAIT_V
#undef PG8_WAIT_L
#undef PG8_BAR
#undef PG8_SCHED
}
}

#ifndef PG8_SP2
#define PG8_SP2 true
#endif
#ifndef PG8_ALIGN
#define PG8_ALIGN true
#endif
constexpr int D = 1024, NB = 4, S = 4096, M = NB * S, DEPTH = 4;
constexpr int INW = 2816, FF = 2816, FF2 = 5632, NMOD = 6144;
constexpr float EPS = 1e-6f;
constexpr float QS = 0.125f * 1.4426950408889634f;
#define LAS __attribute__((address_space(3)))
typedef pg8::bf16_t bf16_t;
typedef pg8::f32x4 f32x4;
typedef pg8::u32x4 u32x4;
typedef unsigned u32x2 __attribute__((ext_vector_type(2)));
using pg8::Unit;

__device__ __forceinline__ unsigned cvt_pk_bf16(float lo, float hi) { unsigned r; asm volatile("v_cvt_pk_bf16_f32 %0, %1, %2" : "=v"(r) : "v"(lo), "v"(hi)); return r; }
__device__ __forceinline__ float bf_lo(unsigned u) { return __uint_as_float(u << 16); }
__device__ __forceinline__ float bf_hi(unsigned u) { return __uint_as_float(u & 0xffff0000u); }
__device__ __forceinline__ float ex2(float x) { return __builtin_amdgcn_exp2f(x); }
__device__ __forceinline__ float lg2(float x) { return __builtin_amdgcn_logf(x); }
__device__ __forceinline__ float rcpf_(float x) { return __builtin_amdgcn_rcpf(x); }
__device__ __forceinline__ float gelu_tanh(float v) { const float u = v + 0.044715f * v * v * v; return v * rcpf_(1.f + ex2(-2.302208199f * u)); }
__device__ __forceinline__ float silu_(float v) { return v * rcpf_(1.f + ex2(-1.4426950409f * v)); }
template <int CTRL> __device__ __forceinline__ float dpp_f(float v) { return __int_as_float(__builtin_amdgcn_update_dpp(0, __float_as_int(v), CTRL, 0xf, 0xf, false)); }
template <int R> __device__ __forceinline__ f32x4 ror4(f32x4 v) { f32x4 r; r[0] = dpp_f<0x120 + R>(v[0]); r[1] = dpp_f<0x120 + R>(v[1]); r[2] = dpp_f<0x120 + R>(v[2]); r[3] = dpp_f<0x120 + R>(v[3]); return r; }

__device__ __forceinline__ float row_rs(const float* ssp, unsigned row) { const f32x4* p = (const f32x4*)((const char*)ssp + row * 64u); const f32x4 a = p[0], b = p[1], c = p[2], d = p[3];
    const f32x4 t = (a + b) + (c + d); return rsqrtf(((t[0] + t[1]) + (t[2] + t[3])) * (1.f / 1024.f) + 1e-6f); }
__device__ __forceinline__ int phys_in(int n0) {
    if (n0 < 512) return n0;
    if (n0 < 1664) return 1280 + (n0 - 512);
    if (n0 < 2432) { const int q = n0 - 1664, hh = q >> 6, half = (q >> 5) & 1; return (2 + (hh >> 2)) * 256 + 128 * half + 32 * (hh & 3); }
    return 1280 + 1152 + (n0 - 2432);
}
__device__ __forceinline__ int phys_up(int n0) { if (n0 < FF) return (n0 >> 7) * 256 + (n0 & 127); const int q = n0 - FF; return (q >> 7) * 256 + 128 + (q & 127); }

constexpr size_t MiB = 1u << 20;
constexpr size_t WS_CTL = 0, WS_MOD = 1 * MiB, WS_SW1 = 2 * MiB, WS_SW2 = 3 * MiB, WS_SS = 4 * MiB, WS_CT = 5 * MiB, WS_ST = 7 * MiB, WS_LSE = 9 * MiB,
                 WS_LASTU = 10 * MiB, WS_FIRSTU = 13 * MiB, WS_YC = 16 * MiB, WS_WIN = 28 * MiB, WS_WOUT = 50 * MiB, WS_WUP = 58 * MiB, WS_WDN = 102 * MiB,
                 WS_HA = 124 * MiB, WS_PROJ = 156 * MiB, WS_YMIX = 244 * MiB, WS_G = 276 * MiB, WS_SSP = 364 * MiB, WS_END = 374 * MiB;
constexpr int RING_BYTES = 131072, HALO_OFF = RING_BYTES, RTAB_OFF = RING_BYTES + 8192, RTAB_UNITS = 16, LDS_BYTES = RTAB_OFF + RTAB_UNITS * 1024;

#define UNPK8(dst, base, v) do { dst[base + 0] = bf_lo(v.x); dst[base + 1] = bf_hi(v.x); dst[base + 2] = bf_lo(v.y); dst[base + 3] = bf_hi(v.y); dst[base + 4] = bf_lo(v.z); dst[base + 5] = bf_hi(v.z); dst[base + 6] = bf_lo(v.w); dst[base + 7] = bf_hi(v.w); } while (0)
struct EpiIn {
    static constexpr bool PERM = true, AFTER_DRAIN = false;
    bf16_t* P; const LAS float* rtab; const float* sw; const float* ct; const float* st;
    __device__ __forceinline__ void operator()(f32x4 (&acc)[2][2][4][2], const Unit& u, int wr, int wc, int fr, int fq, int ui) const {
        { int t_ = threadIdx.x; asm volatile("" : "+v"(t_)); fr = t_ & 15; fq = (t_ >> 4) & 3; }
        const int b = u.pm >> 4; const float* swp = sw + b * INW + u.pn * 256 + wc * 32 + 8 * fq;
        const int row0 = u.pm * 256 + wr * 64 + fr;
        f32x4 sv[2][2];
#pragma unroll
        for (int bj = 0; bj < 2; ++bj)
#pragma unroll
            for (int n = 0; n < 2; ++n) sv[bj][n] = *(const f32x4*)(swp + bj * 128 + 4 * n);
        if (u.pn >= 2 && u.pn <= 4) {
            const int hh = (u.pn - 2) * 4 + wc; const float qs = hh < 6 ? QS : 1.f;
#pragma unroll
            for (int ai = 0; ai < 2; ++ai)
#pragma unroll
                for (int m = 0; m < 4; ++m) { const int row = row0 + ai * 128 + m * 16; const float r = rtab[ui * 256 + (row & 255)];
                    const float* cp = ct + (size_t)row * 32 + 8 * fq; const float* sp = st + (size_t)row * 32 + 8 * fq; u32x4 w1, w2;
#pragma unroll
                    for (int n = 0; n < 2; ++n) { const f32x4 c = *(const f32x4*)(cp + 4 * n), s = *(const f32x4*)(sp + 4 * n);
                        const f32x4 v1 = acc[ai][0][m][n] * r + sv[0][n], v2 = acc[ai][1][m][n] * r + sv[1][n];
                        const f32x4 o1 = (v1 * c - v2 * s) * qs, o2 = (v2 * c + v1 * s) * qs;
                        w1[2 * n] = cvt_pk_bf16(o1[0], o1[1]); w1[2 * n + 1] = cvt_pk_bf16(o1[2], o1[3]); w2[2 * n] = cvt_pk_bf16(o2[0], o2[1]); w2[2 * n + 1] = cvt_pk_bf16(o2[2], o2[3]); }
                    bf16_t* dst = P + (size_t)row * INW + 1664 + hh * 64 + 8 * fq; *(u32x4*)dst = w1; *(u32x4*)(dst + 32) = w2; }
        } else {
            int lc[2]; float sc[2]; const bool gel = u.pn < 2;
#pragma unroll
            for (int bj = 0; bj < 2; ++bj) { if (u.pn < 2) { lc[bj] = u.pn * 256 + bj * 128; sc[bj] = 1.f; }
                else { const int j0 = (u.pn - 5) * 256 + bj * 128; lc[bj] = j0 < 1152 ? 512 + j0 : 2432 + (j0 - 1152); sc[bj] = lc[bj] < 896 ? QS : 1.f; } }
#pragma unroll
            for (int ai = 0; ai < 2; ++ai)
#pragma unroll
                for (int m = 0; m < 4; ++m) { const int row = row0 + ai * 128 + m * 16; const float r = rtab[ui * 256 + (row & 255)];
#pragma unroll
                    for (int bj = 0; bj < 2; ++bj) { f32x4 v0 = acc[ai][bj][m][0] * r + sv[bj][0], v1 = acc[ai][bj][m][1] * r + sv[bj][1];
                        if (gel) {
#pragma unroll
                            for (int e = 0; e < 4; ++e) { v0[e] = gelu_tanh(v0[e]); v1[e] = gelu_tanh(v1[e]); } }
                        else { v0 = v0 * sc[bj]; v1 = v1 * sc[bj]; }
                        u32x4 w; w.x = cvt_pk_bf16(v0[0], v0[1]); w.y = cvt_pk_bf16(v0[2], v0[3]); w.z = cvt_pk_bf16(v1[0], v1[1]); w.w = cvt_pk_bf16(v1[2], v1[3]);
                        *(u32x4*)(P + (size_t)row * INW + lc[bj] + wc * 32 + 8 * fq) = w; } }
        }
    }
};
struct EpiRes {
    static constexpr bool PERM = false, AFTER_DRAIN = false;
    const float* xin; float* xout; const float* gate; float* ssout; const float* gnext; const float* scnext; bf16_t* xs;
    __device__ __forceinline__ void operator()(f32x4 (&acc)[2][2][4][2], const Unit& u, int wr, int wc, int fr, int fq, int ui) const {
        { int t_ = threadIdx.x; asm volatile("" : "+v"(t_)); fr = t_ & 15; fq = (t_ >> 4) & 3; }
        const int b = u.pm >> 4, col0 = u.pn * 256 + wc * 32 + 4 * fq;
        f32x4 gt[2][2], gs[2][2];
#pragma unroll
        for (int bj = 0; bj < 2; ++bj)
#pragma unroll
            for (int n = 0; n < 2; ++n) { const int col = col0 + bj * 128 + n * 16; gt[bj][n] = *(const f32x4*)(gate + b * NMOD + col) + 1.f;
                gs[bj][n] = gnext ? *(const f32x4*)(gnext + col) * (*(const f32x4*)(scnext + b * NMOD + col) + 1.f) : (f32x4){0.f, 0.f, 0.f, 0.f}; }
#pragma unroll
        for (int am = 0; am < 4; ++am) { const int ai = am >> 1, mb = (am & 1) * 2;
            f32x4 pre[2][2][2];
#pragma unroll
            for (int mm = 0; mm < 2; ++mm) { const size_t rb = (size_t)(u.pm * 256 + ai * 128 + wr * 64 + (mb + mm) * 16 + fr) * D + col0;
#pragma unroll
                for (int bj = 0; bj < 2; ++bj)
#pragma unroll
                    for (int n = 0; n < 2; ++n) pre[mm][bj][n] = *(const f32x4*)(xin + rb + bj * 128 + n * 16); }
#pragma unroll
            for (int mm = 0; mm < 2; ++mm) { const int m = mb + mm; const int row = u.pm * 256 + ai * 128 + wr * 64 + m * 16 + fr; float q = 0.f;
#pragma unroll
                for (int bj = 0; bj < 2; ++bj)
#pragma unroll
                    for (int n = 0; n < 2; ++n) { const size_t off = (size_t)row * D + col0 + bj * 128 + n * 16;
                        const f32x4 xn = pre[mm][bj][n] + gt[bj][n] * acc[ai][bj][m][n]; *(f32x4*)(xout + off) = xn;
                        q += (xn[0] * xn[0] + xn[1] * xn[1]) + (xn[2] * xn[2] + xn[3] * xn[3]);
                        if (gnext) { const f32x4 o = xn * gs[bj][n]; u32x2 w; w.x = cvt_pk_bf16(o[0], o[1]); w.y = cvt_pk_bf16(o[2], o[3]); *(u32x2*)(xs + off) = w; } }
                q += __shfl_xor(q, 16); q += __shfl_xor(q, 32);
                if (fq == 0) ssout[(size_t)row * 16 + u.pn * 4 + wc] = q; } }
    }
};
struct EpiU {
    static constexpr bool PERM = true, AFTER_DRAIN = false;
    bf16_t* U; const float* ss; const float* sw; int rowoff;
    __device__ __forceinline__ void operator()(f32x4 (&acc)[2][2][4][2], const Unit& u, int wr, int wc, int fr, int fq, int ui) const {
        { int t_ = threadIdx.x; asm volatile("" : "+v"(t_)); fr = t_ & 15; fq = (t_ >> 4) & 3; }
        const int b = (rowoff >> 12) + (u.pm >> 4), cl = wc * 32 + 8 * fq;
        const unsigned rowl = (unsigned)(u.pm * 256 + wr * 64 + fr);
        f32x4 sv[2][2];
        const char* swb = (const char*)sw + (unsigned)(b * FF2 + u.pn * 256 + cl) * 4u;
#pragma unroll
        for (int bj = 0; bj < 2; ++bj)
#pragma unroll
            for (int n = 0; n < 2; ++n) sv[bj][n] = *(const f32x4*)(swb + (bj * 128 + 4 * n) * 4);
        char* up = (char*)U + (rowl * (unsigned)FF2 + (unsigned)(u.pn * 128 + cl)) * 2u;
#pragma unroll
        for (int ai = 0; ai < 2; ++ai)
#pragma unroll
            for (int m = 0; m < 4; ++m) { const float r = row_rs(ss, (unsigned)rowoff + rowl + ai * 128 + m * 16);
#pragma unroll
                for (int bj = 0; bj < 2; ++bj) { const f32x4 v0 = acc[ai][bj][m][0] * r + sv[bj][0], v1 = acc[ai][bj][m][1] * r + sv[bj][1];
                    u32x4 w; w.x = cvt_pk_bf16(v0[0], v0[1]); w.y = cvt_pk_bf16(v0[2], v0[3]); w.z = cvt_pk_bf16(v1[0], v1[1]); w.w = cvt_pk_bf16(v1[2], v1[3]);
                    *(u32x4*)(up + (unsigned)((ai * 128 + m * 16) * FF2 + bj * FF) * 2u) = w; } }
    }
};
__device__ __forceinline__ u32x4 ld16_agent(const bf16_t* p) { const unsigned long long a = __hip_atomic_load((const unsigned long long*)p, __ATOMIC_RELAXED, __HIP_MEMORY_SCOPE_AGENT), b = __hip_atomic_load((const unsigned long long*)p + 1, __ATOMIC_RELAXED, __HIP_MEMORY_SCOPE_AGENT);
    u32x4 r; r.x = (unsigned)a; r.y = (unsigned)(a >> 32); r.z = (unsigned)b; r.w = (unsigned)(b >> 32); return r; }
struct EpiUc {
    static constexpr bool PERM = true, AFTER_DRAIN = false;
    bf16_t* Gout; const LAS float* rtab; const float* sw; const float* cw; const float* cb; float* lastU; float* firstU; bf16_t* scr2;
    __device__ __forceinline__ void operator()(f32x4 (&acc)[2][2][4][2], const Unit& u, int wr, int wc, int fr, int fq, int ui) const {
        int t_ = threadIdx.x; asm volatile("" : "+v"(t_)); fr = t_ & 15; fq = (t_ >> 4) & 3;
        const int b = u.pm >> 4, cl = wc * 32 + 8 * fq;
        const unsigned rowl = (unsigned)(wr * 64 + fr);
        bf16_t* const scr = scr2 + (size_t)(ui & 1) * 65536;
        { float rr[2][4];
#pragma unroll
          for (int ai = 0; ai < 2; ++ai)
#pragma unroll
              for (int m = 0; m < 4; ++m) rr[ai][m] = rtab[ui * 256 + rowl + ai * 128 + m * 16];
          const unsigned so = (unsigned)(b * FF2 + u.pn * 256 + cl) * 4u;
#pragma unroll
          for (int bj = 0; bj < 2; ++bj) { const f32x4 sv0 = *(const f32x4*)((const char*)sw + (so + (unsigned)(bj * 512))), sv1 = *(const f32x4*)((const char*)sw + (so + (unsigned)(bj * 512 + 16)));
#pragma unroll
              for (int ai = 0; ai < 2; ++ai)
#pragma unroll
                  for (int m = 0; m < 4; ++m) { const f32x4 v0 = acc[ai][bj][m][0] * rr[ai][m] + sv0, v1 = acc[ai][bj][m][1] * rr[ai][m] + sv1;
                      u32x4 w; w.x = cvt_pk_bf16(v0[0], v0[1]); w.y = cvt_pk_bf16(v0[2], v0[3]); w.z = cvt_pk_bf16(v1[0], v1[1]); w.w = cvt_pk_bf16(v1[2], v1[3]);
                      *(u32x4*)((char*)scr + ((rowl + ai * 128 + m * 16) * 256u + (unsigned)(bj * 128 + cl)) * 2u) = w;
                      if (m == 3 && ai == 1 && wr == 1 && fr >= 14) { float* lp = lastU + ((size_t)u.pm * 2 + (fr - 14)) * FF2 + u.pn * 256 + bj * 128 + cl; *(f32x4*)lp = v0; *(f32x4*)(lp + 4) = v1; }
                      if (m == 0 && ai == 0 && wr == 0 && fr < 2) { float* fp = firstU + ((size_t)u.pm * 2 + fr) * FF2 + u.pn * 256 + bj * 128 + cl; *(f32x4*)fp = v0; *(f32x4*)(fp + 4) = v1; } } } }
        asm volatile("s_waitcnt vmcnt(0)" ::: "memory"); __builtin_amdgcn_s_barrier();
        { const int cgp = t_ & 15, r0 = (t_ >> 4) * 8, gcol = u.pn * 128 + cgp * 8;
          float wg[3][8], wv[3][8], bg[8], bv[8];
#pragma unroll
          for (int k = 0; k < 3; ++k)
#pragma unroll
              for (int e = 0; e < 8; e += 4) { const f32x4 a = *(const f32x4*)(cw + k * FF2 + gcol + e), c2 = *(const f32x4*)(cw + k * FF2 + FF + gcol + e);
#pragma unroll
                  for (int q = 0; q < 4; ++q) { wg[k][e + q] = a[q]; wv[k][e + q] = c2[q]; } }
#pragma unroll
          for (int e = 0; e < 8; e += 4) { const f32x4 a = *(const f32x4*)(cb + gcol + e), c2 = *(const f32x4*)(cb + FF + gcol + e);
#pragma unroll
              for (int q = 0; q < 4; ++q) { bg[e + q] = a[q]; bv[e + q] = c2[q]; } }
          const bf16_t* sp = scr + (size_t)r0 * 256 + cgp * 8;
          u32x4 ua[10], uc[10];
          if (r0 > 0) { ua[0] = ld16_agent(sp - 512); uc[0] = ld16_agent(sp - 512 + 128); ua[1] = ld16_agent(sp - 256); uc[1] = ld16_agent(sp - 256 + 128); }
          else { ua[0] = (u32x4){0u, 0u, 0u, 0u}; uc[0] = ua[0]; ua[1] = ua[0]; uc[1] = ua[0]; }
#pragma unroll
          for (int k = 0; k < 8; ++k) { ua[2 + k] = ld16_agent(sp + k * 256); uc[2 + k] = ld16_agent(sp + k * 256 + 128); }
          float g2[8], g1[8], v2[8], v1_[8];
          UNPK8(g2, 0, ua[0]); UNPK8(v2, 0, uc[0]); UNPK8(g1, 0, ua[1]); UNPK8(v1_, 0, uc[1]);
#pragma unroll
          for (int k = 0; k < 8; ++k) {
              float g0[8], v0[8]; UNPK8(g0, 0, ua[2 + k]); UNPK8(v0, 0, uc[2 + k]);
              float res[8];
#pragma unroll
              for (int e = 0; e < 8; ++e) { const float og = bg[e] + wg[0][e] * g2[e] + wg[1][e] * g1[e] + wg[2][e] * g0[e], ov = bv[e] + wv[0][e] * v2[e] + wv[1][e] * v1_[e] + wv[2][e] * v0[e];
                  res[e] = silu_(og) * ov; g2[e] = g1[e]; g1[e] = g0[e]; v2[e] = v1_[e]; v1_[e] = v0[e]; }
              u32x4 w; w.x = cvt_pk_bf16(res[0], res[1]); w.y = cvt_pk_bf16(res[2], res[3]); w.z = cvt_pk_bf16(res[4], res[5]); w.w = cvt_pk_bf16(res[6], res[7]);
              *(u32x4*)(Gout + (size_t)(u.pm * 256 + r0 + k) * FF + gcol) = w; } }
    }
};
struct Args { const float* in[17]; float* out; unsigned char* ws; };

#define XB_TMO      128
#define XB_XCNT(j)  (256  + 64 * (j))
#define XB_XSUB(j)  (1280 + 64 * (j))
#define XB_XGEN(j)  (2304 + 64 * (j))
#define XB_TOP      3328
#define XB_TOPGEN   3392
#define XCD_BAR_WORDS 3456
#define XB_SPIN_CAP (1u << 18)

__device__ __forceinline__ unsigned xb_ld(unsigned* p)              { return __hip_atomic_load(p, __ATOMIC_RELAXED, __HIP_MEMORY_SCOPE_AGENT); }
__device__ __forceinline__ unsigned xb_add(unsigned* p, unsigned v) { return __hip_atomic_fetch_add(p, v, __ATOMIC_RELAXED, __HIP_MEMORY_SCOPE_AGENT); }
__device__ __forceinline__ unsigned xb_xcc_id() { return (unsigned)__builtin_amdgcn_s_getreg((3 << 11) | 20) & 0xFu; }
#define XB_SPIN(cond, bar) do { unsigned _sp = 0; while (cond) { __builtin_amdgcn_s_sleep(1); \
    if ((++_sp & 255u) == 0u) { if (xb_ld(&(bar)[XB_TMO])) break; if (_sp > XB_SPIN_CAP) { atomicAdd(&(bar)[XB_TMO], 1u); break; } } } } while (0)

struct XcdBarrier {
    unsigned* bar; unsigned x;
    volatile LAS unsigned* st;
};

__device__ __forceinline__ XcdBarrier xcd_barrier_post(unsigned* bar, volatile LAS unsigned* st) {
    XcdBarrier b; b.bar = bar; b.x = xb_xcc_id(); b.st = st;
    if (threadIdx.x == 0) (void)xb_add(&bar[XB_XCNT(b.x)], 1u);
    return b;
}
__device__ __forceinline__ void xcd_barrier_complete(unsigned* bar, unsigned x, unsigned& nloc, unsigned& nx) {
    const unsigned G = gridDim.x * gridDim.y * gridDim.z;
    unsigned sum, cnt, mine, sp = 0u;
    for (;;) {
        sum = 0u; cnt = 0u; mine = 0u;
#pragma unroll
        for (unsigned j = 0; j < 16; ++j) { const unsigned c = xb_ld(&bar[XB_XCNT(j)]); sum += c; cnt += (c > 0u) ? 1u : 0u; mine = (j == x) ? c : mine; }
        if (sum == G) break;
        __builtin_amdgcn_s_sleep(1);
        if ((++sp & 255u) == 0u) { if (xb_ld(&bar[XB_TMO])) break; if (sp > XB_SPIN_CAP) { atomicAdd(&bar[XB_TMO], 1u); break; } }
    }
    nloc = mine > 0u ? mine : 1u; nx = cnt > 0u ? cnt : 1u;
}

__device__ __forceinline__ void xcd_barrier(const XcdBarrier& b_in) {
    XcdBarrier b = b_in; b.x = (unsigned)__builtin_amdgcn_readfirstlane((int)xb_xcc_id());
    asm volatile("s_waitcnt vmcnt(0)" ::: "memory");
    __syncthreads();
    if (threadIdx.x == 0) {
        unsigned* bar = b.bar;
        __builtin_amdgcn_s_waitcnt(0);
        unsigned nloc = b.st[0], nx = b.st[1];
        if (nloc == 0u) { xcd_barrier_complete(bar, b.x, nloc, nx); b.st[0] = nloc; b.st[1] = nx; }
        const unsigned old = xb_add(&bar[XB_XSUB(b.x)], 1u);
        const unsigned gen = old / nloc;
        if (old + 1u == (gen + 1u) * nloc) {
            __builtin_amdgcn_fence(__ATOMIC_RELEASE, "agent");
            asm volatile("s_waitcnt vmcnt(0)" ::: "memory");
            const unsigned og = xb_add(&bar[XB_TOP], 1u);
            const unsigned tg = og / nx;
            if (og + 1u == (tg + 1u) * nx) xb_add(&bar[XB_TOPGEN], 1u);
            else XB_SPIN(xb_ld(&bar[XB_TOPGEN]) == tg, bar);
            __builtin_amdgcn_fence(__ATOMIC_ACQUIRE, "agent");
            xb_add(&bar[XB_XGEN(b.x)], 1u);
            asm volatile("s_waitcnt vmcnt(0)" ::: "memory");
        } else {
            XB_SPIN(xb_ld(&bar[XB_XGEN(b.x)]) == gen, bar);
            __builtin_amdgcn_fence(__ATOMIC_ACQUIRE, "agent");
            asm volatile("s_waitcnt vmcnt(0)" ::: "memory");
        }
    }
    __syncthreads();
}

__device__ __forceinline__ void gbar(unsigned* cnt, unsigned& epoch) {
    asm volatile("s_waitcnt vmcnt(0)" ::: "memory");
    __syncthreads();
    epoch += gridDim.x;
    if (threadIdx.x == 0) {
        __builtin_amdgcn_fence(__ATOMIC_RELEASE, "agent");
        asm volatile("s_waitcnt vmcnt(0)" ::: "memory");
        __hip_atomic_fetch_add(cnt, 1u, __ATOMIC_RELAXED, __HIP_MEMORY_SCOPE_AGENT);
        while (__hip_atomic_load(cnt, __ATOMIC_RELAXED, __HIP_MEMORY_SCOPE_AGENT) < epoch) __builtin_amdgcn_s_sleep(1);
        __builtin_amdgcn_fence(__ATOMIC_ACQUIRE, "agent");
        asm volatile("s_waitcnt vmcnt(0)" ::: "memory");
    }
    __syncthreads();
}


template <bool SILU> __device__ __forceinline__ float gemv_item(float* sm, int tid, const float* vsrc, int vstride, const float* W, int N, int j0) {
    const int lane = tid & 63, w = tid >> 6;
    for (int i = tid; i < 4096; i += 512) { const int b = i >> 10, k = i & 1023; const float v = vsrc[(size_t)b * vstride + k]; sm[i] = SILU ? v / (1.f + expf(-v)) : v; }
    __syncthreads();
    float a0 = 0.f, a1 = 0.f, a2 = 0.f, a3 = 0.f;
    const float* wp = W + (size_t)(128 * w) * N + j0 + lane;
#pragma unroll 8
    for (int k = 0; k < 128; ++k) { const float wv = wp[(size_t)k * N]; const int kk = 128 * w + k; a0 += sm[kk] * wv; a1 += sm[1024 + kk] * wv; a2 += sm[2048 + kk] * wv; a3 += sm[3072 + kk] * wv; }
    float* red = sm + 4096;
    red[(w * 4 + 0) * 64 + lane] = a0; red[(w * 4 + 1) * 64 + lane] = a1; red[(w * 4 + 2) * 64 + lane] = a2; red[(w * 4 + 3) * 64 + lane] = a3;
    __syncthreads();
    float s = 0.f;
    if (tid < 256) { const int b = tid >> 6;
#pragma unroll
        for (int ww = 0; ww < 8; ++ww) s += red[(ww * 4 + b) * 64 + lane]; }
    return s;
}
__device__ __forceinline__ void transpose_item(const float* W, int K, int N, bf16_t* WT, int k0, int n0, int prow0, float* scr, int lane) {
#pragma unroll 8
    for (int i = 0; i < 32; ++i) { const int kk = 2 * i + (lane >> 5); scr[kk * 33 + (lane & 31)] = W[(size_t)(k0 + kk) * N + n0 + (lane & 31)]; }
    asm volatile("s_waitcnt lgkmcnt(0)" ::: "memory");
    const int c = lane & 7;
#pragma unroll
    for (int j = 0; j < 4; ++j) { const int n = (lane >> 3) + 8 * j; const float* s = scr + (8 * c) * 33 + n;
        u32x4 o; o.x = cvt_pk_bf16(s[0 * 33], s[1 * 33]); o.y = cvt_pk_bf16(s[2 * 33], s[3 * 33]); o.z = cvt_pk_bf16(s[4 * 33], s[5 * 33]); o.w = cvt_pk_bf16(s[6 * 33], s[7 * 33]);
        *(u32x4*)(WT + (size_t)(prow0 + n) * K + k0 + 8 * c) = o; }
    asm volatile("s_waitcnt lgkmcnt(0)" ::: "memory");
}

__device__ __forceinline__ void mix_a_unit(float* sm, int tid, int unit, const bf16_t* proj, const float* g_sgu, const float* w_sp, const float* b_sp, bf16_t* ymix) {
    float* w = sm; float* vn = sm + 128 * 128;
    const int g = unit & 3, ch = (unit >> 2) & 31, b = unit >> 7; const size_t row0 = (size_t)b * S + ch * 128;
    for (int i = tid; i < 128 * 128; i += 512) { const int t = i >> 7, s = i & 127; w[i] = (s <= t) ? w_sp[(size_t)g * 128 * 128 + i] : 0.f; }
    { const int r = tid >> 2, c0 = (tid & 3) * 16; float v[16]; float ss = 0.f;
      const u32x4* p = (const u32x4*)(proj + (row0 + r) * INW + 256 + g * 64 + c0); const u32x4 v0 = p[0], v1 = p[1];
      UNPK8(v, 0, v0); UNPK8(v, 8, v1);
#pragma unroll
      for (int j = 0; j < 16; ++j) ss += v[j] * v[j];
      ss += __shfl_xor(ss, 1); ss += __shfl_xor(ss, 2);
      const float rr = rsqrtf(ss * (1.f / 64.f) + EPS);
#pragma unroll
      for (int j = 0; j < 16; ++j) vn[r * 64 + c0 + j] = v[j] * rr * g_sgu[g * 64 + c0 + j]; }
    __syncthreads();
    const int tq = tid >> 4, cq = tid & 15;
    float acc[4][4];
#pragma unroll
    for (int i = 0; i < 4; ++i)
#pragma unroll
        for (int j = 0; j < 4; ++j) acc[i][j] = 0.f;
    for (int s = 0; s <= 4 * tq + 3; ++s) { const f32x4 vv = *(const f32x4*)&vn[s * 64 + 4 * cq];
#pragma unroll
        for (int i = 0; i < 4; ++i) { const float wv = w[(4 * tq + i) * 128 + s]; acc[i][0] += wv * vv[0]; acc[i][1] += wv * vv[1]; acc[i][2] += wv * vv[2]; acc[i][3] += wv * vv[3]; } }
#pragma unroll
    for (int i = 0; i < 4; ++i) { const int t = 4 * tq + i; const float bb = b_sp[g * 128 + t];
        const u32x2 uu = *(const u32x2*)(proj + (row0 + t) * INW + g * 64 + 4 * cq);
        u32x2 o; o.x = cvt_pk_bf16(bf_lo(uu.x) * (acc[i][0] + bb), bf_hi(uu.x) * (acc[i][1] + bb)); o.y = cvt_pk_bf16(bf_lo(uu.y) * (acc[i][2] + bb), bf_hi(uu.y) * (acc[i][3] + bb));
        *(u32x2*)(ymix + (row0 + t) * D + g * 64 + 4 * cq) = o; }
    __syncthreads();
}
__device__ __forceinline__ void mix_a_unit_mfma(unsigned char* smb, int tid, int unit, const bf16_t* proj, const float* g_sgu, const float* w_sp, const float* b_sp, bf16_t* ymix) {
    constexpr int VS = 136;
    bf16_t* vnT = (bf16_t*)smb;
    const int g = unit & 3, ch = (unit >> 2) & 31, b = unit >> 7, lane = tid & 63, wv = tid >> 6; const size_t row0 = (size_t)b * S + ch * 128;
    { const int r = tid >> 2, c0 = (tid & 3) * 16; float v[16]; float ss = 0.f;
      const u32x4* p = (const u32x4*)(proj + (row0 + r) * INW + 256 + g * 64 + c0); const u32x4 v0 = p[0], v1 = p[1];
      UNPK8(v, 0, v0); UNPK8(v, 8, v1);
#pragma unroll
      for (int j = 0; j < 16; ++j) ss += v[j] * v[j];
      ss += __shfl_xor(ss, 1); ss += __shfl_xor(ss, 2);
      const float rr = rsqrtf(ss * (1.f / 64.f) + EPS);
#pragma unroll
      for (int j = 0; j < 16; j += 2) { const unsigned pk = cvt_pk_bf16(v[j] * rr * g_sgu[g * 64 + c0 + j], v[j + 1] * rr * g_sgu[g * 64 + c0 + j + 1]);
          vnT[(c0 + j) * VS + r] = (bf16_t)(pk & 0xffffu); vnT[(c0 + j + 1) * VS + r] = (bf16_t)(pk >> 16); } }
    __syncthreads();
    const int tr = lane & 15, quad = lane >> 4, t0 = 16 * wv;
    f32x4 acc[4];
#pragma unroll
    for (int ct = 0; ct < 4; ++ct) acc[ct] = (f32x4){0.f, 0.f, 0.f, 0.f};
    const float* wrow = w_sp + ((size_t)g * 128 + t0 + tr) * 128;
    const int nks = (t0 + 15) / 32 + 1;
    for (int ks = 0; ks < nks; ++ks) { const int s0 = 32 * ks + 8 * quad; const f32x4 a0 = *(const f32x4*)(wrow + s0), a1 = *(const f32x4*)(wrow + s0 + 4);
        float aw[8] = {a0[0], a0[1], a0[2], a0[3], a1[0], a1[1], a1[2], a1[3]};
#pragma unroll
        for (int j = 0; j < 8; ++j) if (s0 + j > t0 + tr) aw[j] = 0.f;
        u32x4 ap; ap.x = cvt_pk_bf16(aw[0], aw[1]); ap.y = cvt_pk_bf16(aw[2], aw[3]); ap.z = cvt_pk_bf16(aw[4], aw[5]); ap.w = cvt_pk_bf16(aw[6], aw[7]);
        const pg8::bf16x8 af = __builtin_bit_cast(pg8::bf16x8, ap);
#pragma unroll
        for (int ct = 0; ct < 4; ++ct) { const pg8::bf16x8 bfr = *(const pg8::bf16x8*)(vnT + (16 * ct + tr) * VS + s0);
            acc[ct] = __builtin_amdgcn_mfma_f32_16x16x32_bf16(af, bfr, acc[ct], 0, 0, 0); } }
#pragma unroll
    for (int j = 0; j < 4; ++j) { const int t = t0 + quad * 4 + j; const float bb = b_sp[g * 128 + t];
#pragma unroll
        for (int ct = 0; ct < 4; ++ct) { const int c = g * 64 + 16 * ct + tr; const float u = bf_lo((unsigned)proj[(row0 + t) * INW + c]);
            const unsigned pk = cvt_pk_bf16(u * (acc[ct][j] + bb), 0.f); ymix[(row0 + t) * D + c] = (bf16_t)(pk & 0xffffu); } }
    __syncthreads();
}
__device__ __forceinline__ void mix_b_naive(int item, int lane, const bf16_t* proj, bf16_t* ymix) {
    const int qb = 63 - item / 24, bh = item % 24, b = bh / 6, h = bh % 6, t = qb * 64 + lane; const size_t rb = (size_t)b * S;
    float q[64], o[64];
    { const u32x4* p = (const u32x4*)(proj + (rb + t) * INW + 512 + h * 64);
#pragma unroll
      for (int c = 0; c < 8; ++c) { const u32x4 v = p[c]; UNPK8(q, 8 * c, v); } }
#pragma unroll
    for (int d = 0; d < 64; ++d) o[d] = 0.f;
    float C = 0.f;
    for (int s = qb * 64 + 62; s >= 0; --s) {
        const u32x4* kp = (const u32x4*)(proj + (rb + s) * INW + 896 + h * 64); const u32x4* vp = (const u32x4*)(proj + (rb + s) * INW + 1280 + h * 64);
        float z = 0.f;
#pragma unroll
        for (int c = 0; c < 8; ++c) { const u32x4 v = kp[c]; float kk[8]; UNPK8(kk, 0, v);
#pragma unroll
            for (int e = 0; e < 8; ++e) z += q[8 * c + e] * kk[e]; }
        float wgt = 0.f;
        if (s < t) { z = fminf(z, 100.f); const float sp = lg2(1.f + ex2(z)); C += sp; wgt = ex2(z - C); }
#pragma unroll
        for (int c = 0; c < 8; ++c) { const u32x4 v = vp[c]; float vv[8]; UNPK8(vv, 0, v);
#pragma unroll
            for (int e = 0; e < 8; ++e) o[8 * c + e] += wgt * vv[e]; }
    }
    u32x4* op = (u32x4*)(ymix + (rb + t) * D + 256 + h * 64);
#pragma unroll
    for (int c = 0; c < 8; ++c) { u32x4 w; w.x = cvt_pk_bf16(o[8 * c], o[8 * c + 1]); w.y = cvt_pk_bf16(o[8 * c + 2], o[8 * c + 3]); w.z = cvt_pk_bf16(o[8 * c + 4], o[8 * c + 5]); w.w = cvt_pk_bf16(o[8 * c + 6], o[8 * c + 7]); op[c] = w; }
}
__device__ __forceinline__ void mix_c_naive(int item, int lane, const bf16_t* proj, bf16_t* ycraw, float* lse) {
    const int h = item % 6, row = (item / 6) * 64 + lane, b = row / S, t = row % S, dil = (h < 2) ? 1 : (h < 4 ? 4 : 16);
    float q[64], o[64];
    { const u32x4* p = (const u32x4*)(proj + (size_t)row * INW + 1664 + h * 64);
#pragma unroll
      for (int c = 0; c < 8; ++c) { const u32x4 v = p[c]; UNPK8(q, 8 * c, v); } }
#pragma unroll
    for (int d = 0; d < 64; ++d) o[d] = 0.f;
    float mx = -INFINITY, l = 0.f;
    for (int m = 0; m <= 128; ++m) { const int idx = t - m * dil; const bool valid = idx >= 0; const int ic = idx < 0 ? 0 : idx;
        const u32x4* kp = (const u32x4*)(proj + ((size_t)b * S + ic) * INW + 2048 + h * 64); const u32x4* vp = (const u32x4*)(proj + ((size_t)b * S + ic) * INW + 2432 + h * 64);
        float z = 0.f;
#pragma unroll
        for (int c = 0; c < 8; ++c) { const u32x4 v = kp[c]; float kk[8]; UNPK8(kk, 0, v);
#pragma unroll
            for (int e = 0; e < 8; ++e) z += q[8 * c + e] * kk[e]; }
        float f = 1.f, p = 0.f;
        if (valid) { const float mn = fmaxf(mx, z); f = ex2(mx - mn); p = ex2(z - mn); mx = mn; }
        l = l * f + p;
#pragma unroll
        for (int c = 0; c < 8; ++c) { const u32x4 v = vp[c]; float vv[8]; UNPK8(vv, 0, v);
#pragma unroll
            for (int e = 0; e < 8; ++e) o[8 * c + e] = o[8 * c + e] * f + p * vv[e]; }
    }
    const float il = 1.f / l;
    u32x4* op = (u32x4*)(ycraw + (size_t)row * 384 + h * 64);
#pragma unroll
    for (int c = 0; c < 8; ++c) { u32x4 w; w.x = cvt_pk_bf16(o[8 * c] * il, o[8 * c + 1] * il); w.y = cvt_pk_bf16(o[8 * c + 2] * il, o[8 * c + 3] * il); w.z = cvt_pk_bf16(o[8 * c + 4] * il, o[8 * c + 5] * il); w.w = cvt_pk_bf16(o[8 * c + 6] * il, o[8 * c + 7] * il); op[c] = w; }
    lse[(size_t)row * 6 + h] = mx + lg2(l);
}
namespace att {
typedef short bf16x8 __attribute__((ext_vector_type(8)));
typedef short s16x4 __attribute__((ext_vector_type(4)));
typedef float f32x16 __attribute__((ext_vector_type(16)));
constexpr int SLOTB = 8192, LDS_K = 0, LDS_V = 3 * SLOTB, LDS_WS = 6 * SLOTB, LDS_OST = LDS_WS + 8 * 64 * 4, LDS_TOT = LDS_OST + 8 * 4096;
__device__ __forceinline__ int crow(int r, int hi) { return (r & 3) + 8 * (r >> 2) + 4 * hi; }
__device__ __forceinline__ void glds16(const void* gsrc, unsigned lds_dst) { unsigned keep;
    asm volatile("s_mov_b32 %0, m0\n\ts_mov_b32 m0, %2\n\ts_nop 0\n\tglobal_load_lds_dwordx4 %1, off\n\ts_mov_b32 m0, %0" : "=&s"(keep) : "v"(gsrc), "s"(lds_dst) : "memory"); }
__device__ __forceinline__ float swapmax(float m) { auto rr = __builtin_amdgcn_permlane32_swap(__float_as_uint(m), __float_as_uint(m), false, false); return fmaxf(__uint_as_float(rr[0]), __uint_as_float(rr[1])); }
__device__ __forceinline__ float swapadd(float m) { auto rr = __builtin_amdgcn_permlane32_swap(__float_as_uint(m), __float_as_uint(m), false, false); return __uint_as_float(rr[0]) + __uint_as_float(rr[1]); }
#define ATT_WAIT_BAR(N) asm volatile("s_waitcnt vmcnt(" #N ") lgkmcnt(0)\n\ts_barrier" ::: "memory")
__device__ __forceinline__ void pv(f32x16* o, int vb, bf16x8 pa0, bf16x8 pa1, bf16x8 pa2, bf16x8 pa3) {
#pragma unroll
    for (int d0 = 0; d0 < 2; ++d0) { s16x4 lo[4], hi[4];
#pragma unroll
        for (int ks = 0; ks < 4; ++ks) {
            asm volatile("ds_read_b64_tr_b16 %0,%1 offset:%c2" : "=&v"(lo[ks]) : "v"(vb), "i"(d0 * 4096 + ks * 1024) : "memory");
            asm volatile("ds_read_b64_tr_b16 %0,%1 offset:%c2" : "=&v"(hi[ks]) : "v"(vb), "i"(d0 * 4096 + ks * 1024 + 512) : "memory"); }
        asm volatile("s_waitcnt lgkmcnt(0)" ::: "memory"); __builtin_amdgcn_sched_barrier(0);
#define ATT_PK(k) (bf16x8){lo[k][0], lo[k][1], lo[k][2], lo[k][3], hi[k][0], hi[k][1], hi[k][2], hi[k][3]}
        o[d0] = __builtin_amdgcn_mfma_f32_32x32x16_bf16(pa0, ATT_PK(0), o[d0], 0, 0, 0);
        o[d0] = __builtin_amdgcn_mfma_f32_32x32x16_bf16(pa1, ATT_PK(1), o[d0], 0, 0, 0);
        o[d0] = __builtin_amdgcn_mfma_f32_32x32x16_bf16(pa2, ATT_PK(2), o[d0], 0, 0, 0);
        o[d0] = __builtin_amdgcn_mfma_f32_32x32x16_bf16(pa3, ATT_PK(3), o[d0], 0, 0, 0);
#undef ATT_PK
    }
}
__device__ __forceinline__ bf16x8 pack8(const f32x16& p, int base) { u32x4 w; w.x = cvt_pk_bf16(p[base], p[base + 1]); w.y = cvt_pk_bf16(p[base + 2], p[base + 3]); w.z = cvt_pk_bf16(p[base + 4], p[base + 5]); w.w = cvt_pk_bf16(p[base + 6], p[base + 7]); return __builtin_bit_cast(bf16x8, w); }

template <int MODE>
__device__ __forceinline__ void unit(LAS unsigned char* shm, const bf16_t* proj, int rowbase, int res, int dil, int q0, int T_lo, int T_hi, int qcol, int kcol, int vcol,
                                     bf16_t* O, int opitch, int ocol, float* lse, int h) {
    int tid_l = threadIdx.x; asm volatile("" : "+v"(tid_l));
    const int tid = tid_l, lane = tid & 63, r32 = lane & 31, hi = lane >> 5; const int wid = __builtin_amdgcn_readfirstlane(tid >> 6);
    const unsigned lds0 = (unsigned)(uintptr_t)shm;
    LAS float* wsf = (LAS float*)(shm + LDS_WS) + wid * 64;
    const size_t tok0 = (size_t)rowbase + res;
    const bf16_t* ksrc = proj + (tok0 + (size_t)dil * lane) * INW + kcol + wid * 8;
    const bf16_t* vsrc = proj + (tok0 + (size_t)dil * (16 * (wid & 3) + (lane >> 2))) * INW + vcol + (wid >> 2) * 32 + (lane & 3) * 8;
    const size_t tstep = (size_t)dil * 64 * INW;
    const unsigned kdst = lds0 + LDS_K + wid * 1024, vdst = lds0 + LDS_V + wid * 1024;
#define ATT_DMA(t, slot) do { glds16(ksrc + (size_t)(t) * tstep, (unsigned)__builtin_amdgcn_readfirstlane(kdst + (slot) * SLOTB)); glds16(vsrc + (size_t)(t) * tstep, (unsigned)__builtin_amdgcn_readfirstlane(vdst + (slot) * SLOTB)); } while (0)
    const int vb0 = (int)(lds0 + LDS_V) + ((lane >> 4) & 1) * 32 + (lane & 3) * 8 + (4 * hi + ((lane & 15) >> 2)) * 64;
    const int qpos = q0 + wid * 32 + r32, qmin = q0 + wid * 32, qmax = qmin + 31;
    const int NT = T_hi - T_lo + 1;
    ATT_DMA(T_hi, 0); if (NT > 1) ATT_DMA(T_hi - 1, 1);
    bf16x8 qr[4];
    { const bf16_t* qp = proj + (tok0 + (size_t)dil * qpos) * INW + qcol + hi * 8;
#pragma unroll
      for (int d0 = 0; d0 < 4; ++d0) qr[d0] = *(const bf16x8*)(qp + d0 * 16); }
    asm volatile("s_waitcnt vmcnt(0)" : "+v"(qr[0]), "+v"(qr[1]), "+v"(qr[2]), "+v"(qr[3]) :: "memory");
    bf16x8 ua0, ua1, ones;
    { u32x4 a, b; unsigned av[8], bv[8];
#pragma unroll
      for (int j = 0; j < 8; ++j) { const int kvk = 8 * (j >> 2) + 4 * hi + (j & 3); av[j] = kvk >= r32 ? 0x3f80u : 0u; bv[j] = kvk + 16 >= r32 ? 0x3f80u : 0u; }
      a.x = av[0] | (av[1] << 16); a.y = av[2] | (av[3] << 16); a.z = av[4] | (av[5] << 16); a.w = av[6] | (av[7] << 16);
      b.x = bv[0] | (bv[1] << 16); b.y = bv[2] | (bv[3] << 16); b.z = bv[4] | (bv[5] << 16); b.w = bv[6] | (bv[7] << 16);
      ua0 = __builtin_bit_cast(bf16x8, a); ua1 = __builtin_bit_cast(bf16x8, b); const u32x4 o1 = {0x3f803f80u, 0x3f803f80u, 0x3f803f80u, 0x3f803f80u}; ones = __builtin_bit_cast(bf16x8, o1); }
    f32x16 o[2]; o[0] = f32x16{}; o[1] = f32x16{};
    float carry = 0.f, mrun = -INFINITY, lrun = 0.f;
    for (int n = 0; n < NT; ++n) { const int kt = T_hi - n; const int slot = n % 3;
        if (n + 1 < NT) ATT_WAIT_BAR(2); else ATT_WAIT_BAR(0);
        if (n + 2 < NT) ATT_DMA(kt - 2, (n + 2) % 3);
        const int kmin = kt * 64, kmax = kmin + 63;
        bool need, full;
        if (MODE == 0) { need = kmin < qmax; full = kmax < qmin; } else { need = (kmin <= qmax) && (kmax >= qmin - 128); full = (kmax <= qmin) && (kmin >= qmax - 128); }
        if (!need) continue;
        f32x16 p0 = f32x16{}, p1 = f32x16{};
        { const LAS unsigned char* kb = shm + LDS_K + slot * SLOTB + hi * 1024 + r32 * 16;
#pragma unroll
          for (int d0 = 0; d0 < 4; ++d0) { const bf16x8 b0 = *(const LAS bf16x8*)(kb + d0 * 2048), b1 = *(const LAS bf16x8*)(kb + d0 * 2048 + 512);
              p0 = __builtin_amdgcn_mfma_f32_32x32x16_bf16(b0, qr[d0], p0, 0, 0, 0); p1 = __builtin_amdgcn_mfma_f32_32x32x16_bf16(b1, qr[d0], p1, 0, 0, 0); } }
        const int kb0 = kmin + 4 * hi;
        if (MODE == 0) {
            f32x16 s0, s1;
#pragma unroll
            for (int r = 0; r < 16; ++r) { const int kv = kb0 + (r & 3) + 8 * (r >> 2);
                p0[r] = fminf(p0[r], 100.f); p1[r] = fminf(p1[r], 100.f);
                float a = lg2(1.f + ex2(p0[r])), b = lg2(1.f + ex2(p1[r]));
                if (!full) { if (kv >= qpos) a = 0.f; if (kv + 32 >= qpos) b = 0.f; }
                s0[r] = a; s1[r] = b; }
            const bf16x8 q0_ = pack8(s0, 0), q1_ = pack8(s0, 8), q2_ = pack8(s1, 0), q3_ = pack8(s1, 8);
            f32x16 c0 = f32x16{}, c1 = f32x16{};
            c0 = __builtin_amdgcn_mfma_f32_32x32x16_bf16(ua0, q0_, c0, 0, 0, 0); c0 = __builtin_amdgcn_mfma_f32_32x32x16_bf16(ua1, q1_, c0, 0, 0, 0);
            c0 = __builtin_amdgcn_mfma_f32_32x32x16_bf16(ones, q2_, c0, 0, 0, 0); c0 = __builtin_amdgcn_mfma_f32_32x32x16_bf16(ones, q3_, c0, 0, 0, 0);
            c1 = __builtin_amdgcn_mfma_f32_32x32x16_bf16(ua0, q2_, c1, 0, 0, 0); c1 = __builtin_amdgcn_mfma_f32_32x32x16_bf16(ua1, q3_, c1, 0, 0, 0);
#pragma unroll
            for (int r = 0; r < 16; ++r) { const int kv = kb0 + (r & 3) + 8 * (r >> 2);
                float a = ex2(p0[r] - c0[r] - carry), b = ex2(p1[r] - c1[r] - carry);
                if (!full) { if (kv >= qpos) a = 0.f; if (kv + 32 >= qpos) b = 0.f; }
                p0[r] = a; p1[r] = b; }
            carry += __shfl(c0[0], r32);
        } else {
            if (!full) {
#pragma unroll
                for (int r = 0; r < 16; ++r) { const int kv = kb0 + (r & 3) + 8 * (r >> 2);
                    if (kv > qpos || kv < qpos - 128) p0[r] = -INFINITY; if (kv + 32 > qpos || kv + 32 < qpos - 128) p1[r] = -INFINITY; } }
            float rm = fmaxf(p0[0], p1[0]);
#pragma unroll
            for (int r = 1; r < 16; ++r) rm = fmaxf(rm, fmaxf(p0[r], p1[r]));
            rm = swapmax(rm);
            const float mnew = fmaxf(mrun, rm), muse = mnew == -INFINITY ? 0.f : mnew, f = ex2(mrun - muse);
            float rs = 0.f;
#pragma unroll
            for (int r = 0; r < 16; ++r) { p0[r] = ex2(p0[r] - muse); p1[r] = ex2(p1[r] - muse); rs += p0[r] + p1[r]; }
            lrun = lrun * f + rs; mrun = mnew;
            if (hi == 0) wsf[r32] = f;
            asm volatile("s_waitcnt lgkmcnt(0)" ::: "memory");
#pragma unroll
            for (int r = 0; r < 16; ++r) { const float fr_ = wsf[crow(r, hi)]; o[0][r] *= fr_; o[1][r] *= fr_; }
        }
        pv(o, vb0 + slot * SLOTB, pack8(p0, 0), pack8(p0, 8), pack8(p1, 0), pack8(p1, 8));
    }
    float rli[16];
    if (MODE == 1) { const float lt = swapadd(lrun); if (hi == 0) { wsf[32 + r32] = lt; lse[(tok0 + (size_t)dil * qpos) * 6 + h] = mrun + lg2(lt); }
        asm volatile("s_waitcnt lgkmcnt(0)" ::: "memory");
#pragma unroll
        for (int r = 0; r < 16; ++r) rli[r] = rcpf_(wsf[32 + crow(r, hi)]); }
    else {
#pragma unroll
        for (int r = 0; r < 16; ++r) rli[r] = 1.f; }
    { LAS bf16_t* stg = (LAS bf16_t*)(shm + LDS_OST) + wid * 2048;
#pragma unroll
      for (int r = 0; r < 16; ++r) { const int orow = crow(r, hi);
#pragma unroll
          for (int d0 = 0; d0 < 2; ++d0) { const unsigned pk = cvt_pk_bf16(o[d0][r] * rli[r], 0.f); stg[orow * 64 + d0 * 32 + r32] = (bf16_t)(pk & 0xffffu); } }
      asm volatile("s_waitcnt lgkmcnt(0)" ::: "memory");
#pragma unroll
      for (int i = 0; i < 4; ++i) { const int row = i * 8 + (lane >> 3), ch = lane & 7; const u32x4 v = *(const LAS u32x4*)(stg + row * 64 + ch * 8);
          *(u32x4*)(O + (tok0 + (size_t)dil * (qmin + row)) * opitch + ocol + ch * 8) = v; } }
    asm volatile("s_waitcnt lgkmcnt(0)\n\ts_barrier" ::: "memory");
#undef ATT_DMA
}
constexpr float SB_TAU = 48.f;
__device__ __forceinline__ void unit_sb(LAS unsigned char* shm, const bf16_t* proj, int rowbase, int q0, int T_hi, int qcol, int kcol, int vcol, bf16_t* O, int opitch, int ocol) {
    int tid_l = threadIdx.x; asm volatile("" : "+v"(tid_l));
    const int tid = tid_l, lane = tid & 63, r32 = lane & 31, hi = lane >> 5; const int wid = __builtin_amdgcn_readfirstlane(tid >> 6);
    const unsigned lds0 = (unsigned)(uintptr_t)shm;
    const size_t tok0 = (size_t)rowbase;
    const bf16_t* ksrc = proj + (tok0 + lane) * INW + kcol + wid * 8;
    const bf16_t* vsrc = proj + (tok0 + (16 * (wid & 3) + (lane >> 2))) * INW + vcol + (wid >> 2) * 32 + (lane & 3) * 8;
    const size_t tstep = (size_t)64 * INW;
    const unsigned kdst = lds0 + LDS_K + wid * 1024, vdst = lds0 + LDS_V + wid * 1024;
    const int NT = T_hi + 1;
#define SB_DMAK(n) do { const int n_ = (n) < NT ? (n) : NT - 1; glds16(ksrc + (size_t)(T_hi - n_) * tstep, (unsigned)__builtin_amdgcn_readfirstlane(kdst + ((n) % 3) * SLOTB)); } while (0)
#define SB_DMAV(n) do { const int n_ = (n) < NT ? (n) : NT - 1; glds16(vsrc + (size_t)(T_hi - n_) * tstep, (unsigned)__builtin_amdgcn_readfirstlane(vdst + ((n) % 3) * SLOTB)); } while (0)
    const int vb0 = (int)(lds0 + LDS_V) + ((lane >> 4) & 1) * 32 + (lane & 3) * 8 + (4 * hi + ((lane & 15) >> 2)) * 64;
    const int qpos = q0 + wid * 32 + r32, qmin = q0 + wid * 32, qmax = qmin + 31;
    SB_DMAK(0); SB_DMAK(1); SB_DMAV(0); SB_DMAK(2); SB_DMAV(1);
    bf16x8 qr[4];
    { const bf16_t* qp = proj + (tok0 + qpos) * INW + qcol + hi * 8;
#pragma unroll
      for (int d0 = 0; d0 < 4; ++d0) qr[d0] = *(const bf16x8*)(qp + d0 * 16); }
    bf16x8 ua0, ua1, ones;
    { u32x4 a, b; unsigned av[8], bv[8];
#pragma unroll
      for (int j = 0; j < 8; ++j) { const int kvk = 8 * (j >> 2) + 4 * hi + (j & 3); av[j] = kvk >= r32 ? 0x3f80u : 0u; bv[j] = kvk + 16 >= r32 ? 0x3f80u : 0u; }
      a.x = av[0] | (av[1] << 16); a.y = av[2] | (av[3] << 16); a.z = av[4] | (av[5] << 16); a.w = av[6] | (av[7] << 16);
      b.x = bv[0] | (bv[1] << 16); b.y = bv[2] | (bv[3] << 16); b.z = bv[4] | (bv[5] << 16); b.w = bv[6] | (bv[7] << 16);
      ua0 = __builtin_bit_cast(bf16x8, a); ua1 = __builtin_bit_cast(bf16x8, b); const u32x4 o1 = {0x3f803f80u, 0x3f803f80u, 0x3f803f80u, 0x3f803f80u}; ones = __builtin_bit_cast(bf16x8, o1); }
    f32x16 o[2]; o[0] = f32x16{}; o[1] = f32x16{};
    float carry = 0.f;
#define SB_STAGE_A(n, d0_, d1_, tot_) do { const int kmin_ = (T_hi - (n)) * 64; const bool full_ = kmin_ + 63 < qmin; const int kb0_ = kmin_ + 4 * hi; \
        f32x16 p0_ = f32x16{}, p1_ = f32x16{}; \
        { const LAS unsigned char* kb_ = shm + LDS_K + ((n) % 3) * SLOTB + hi * 1024 + r32 * 16; \
          _Pragma("unroll") for (int dd = 0; dd < 4; ++dd) { const bf16x8 b0 = *(const LAS bf16x8*)(kb_ + dd * 2048), b1 = *(const LAS bf16x8*)(kb_ + dd * 2048 + 512); \
              p0_ = __builtin_amdgcn_mfma_f32_32x32x16_bf16(b0, qr[dd], p0_, 0, 0, 0); p1_ = __builtin_amdgcn_mfma_f32_32x32x16_bf16(b1, qr[dd], p1_, 0, 0, 0); } } \
        f32x16 s0_, s1_; \
        _Pragma("unroll") for (int r = 0; r < 16; ++r) { const int kv = kb0_ + (r & 3) + 8 * (r >> 2); \
            p0_[r] = fminf(p0_[r], 100.f); p1_[r] = fminf(p1_[r], 100.f); \
            float a_ = lg2(1.f + ex2(p0_[r])), b_ = lg2(1.f + ex2(p1_[r])); \
            if (!full_) { if (kv >= qpos) { a_ = 0.f; p0_[r] = -INFINITY; } if (kv + 32 >= qpos) { b_ = 0.f; p1_[r] = -INFINITY; } } \
            s0_[r] = a_; s1_[r] = b_; } \
        const bf16x8 q0_ = pack8(s0_, 0), q1_ = pack8(s0_, 8), q2_ = pack8(s1_, 0), q3_ = pack8(s1_, 8); \
        f32x16 c0_ = f32x16{}, c1_ = f32x16{}; \
        c0_ = __builtin_amdgcn_mfma_f32_32x32x16_bf16(ua0, q0_, c0_, 0, 0, 0); c1_ = __builtin_amdgcn_mfma_f32_32x32x16_bf16(ua0, q2_, c1_, 0, 0, 0); \
        c0_ = __builtin_amdgcn_mfma_f32_32x32x16_bf16(ua1, q1_, c0_, 0, 0, 0); c1_ = __builtin_amdgcn_mfma_f32_32x32x16_bf16(ua1, q3_, c1_, 0, 0, 0); \
        c0_ = __builtin_amdgcn_mfma_f32_32x32x16_bf16(ones, q2_, c0_, 0, 0, 0); c0_ = __builtin_amdgcn_mfma_f32_32x32x16_bf16(ones, q3_, c0_, 0, 0, 0); \
        _Pragma("unroll") for (int r = 0; r < 16; ++r) { d0_[r] = p0_[r] - c0_[r]; d1_[r] = p1_[r] - c1_[r]; } \
        tot_ = __shfl(c0_[0], r32); } while (0)
    f32x16 dC0 = f32x16{}, dC1 = f32x16{}; float totC = 0.f;
    asm volatile("s_waitcnt vmcnt(0)\n\ts_barrier" : "+v"(qr[0]), "+v"(qr[1]), "+v"(qr[2]), "+v"(qr[3]) :: "memory");
    bool needC = (T_hi * 64) < qmax;
    if (needC) SB_STAGE_A(0, dC0, dC1, totC);
    LAS unsigned* flagp = (LAS unsigned*)(shm + LDS_WS);
    for (int n = 0; n < NT; ++n) {
        ATT_WAIT_BAR(2);
        if (n > 0) { const unsigned f = flagp[(lane & 7) * 64 + 60 + ((n - 1) & 1)]; if (__builtin_amdgcn_ballot_w64(f != 0u) == ~0ull) break; }
        SB_DMAK(n + 3); SB_DMAV(n + 2);
        f32x16 dN0 = f32x16{}, dN1 = f32x16{}; float totN = 0.f;
        const bool needN = (n + 1 < NT) && ((T_hi - (n + 1)) * 64 < qmax);
        if (needN) SB_STAGE_A(n + 1, dN0, dN1, totN);
        if (needC) {
#pragma unroll
            for (int r = 0; r < 16; ++r) { dC0[r] = ex2(dC0[r] - carry); dC1[r] = ex2(dC1[r] - carry); }
            carry += totC;
            pv(o, vb0 + (n % 3) * SLOTB, pack8(dC0, 0), pack8(dC0, 8), pack8(dC1, 0), pack8(dC1, 8));
        }
        { const bool sat = __builtin_amdgcn_ballot_w64(carry >= SB_TAU) == ~0ull; if (lane == 0) flagp[wid * 64 + 60 + (n & 1)] = sat ? 1u : 0u; }
        dC0 = dN0; dC1 = dN1; totC = totN; needC = needN;
    }
    asm volatile("s_waitcnt vmcnt(0)" ::: "memory");
    { LAS bf16_t* stg = (LAS bf16_t*)(shm + LDS_OST) + wid * 2048;
#pragma unroll
      for (int r = 0; r < 16; ++r) { const int orow = crow(r, hi);
#pragma unroll
          for (int d0 = 0; d0 < 2; ++d0) { const unsigned pk = cvt_pk_bf16(o[d0][r], 0.f); stg[orow * 64 + d0 * 32 + r32] = (bf16_t)(pk & 0xffffu); } }
      asm volatile("s_waitcnt lgkmcnt(0)" ::: "memory");
#pragma unroll
      for (int i = 0; i < 4; ++i) { const int row = i * 8 + (lane >> 3), ch = lane & 7; const u32x4 v = *(const LAS u32x4*)(stg + row * 64 + ch * 8);
          *(u32x4*)(O + (tok0 + (qmin + row)) * opitch + ocol + ch * 8) = v; } }
    asm volatile("s_waitcnt lgkmcnt(0)\n\ts_barrier" ::: "memory");
#undef SB_DMAK
#undef SB_DMAV
#undef SB_STAGE_A
}
#undef ATT_WAIT_BAR
}
#define RTAB_BUILD(So_, ssp_) do { int tq_ = threadIdx.x; asm volatile("" : "+v"(tq_)); Unit uq_; \
    for (int i_ = __builtin_amdgcn_readfirstlane(tq_ >> 8); i_ < RTAB_UNITS && (So_).next(i_, uq_); i_ += 2) ((LAS float*)(lds + RTAB_OFF))[i_ * 256 + (tq_ & 255)] = row_rs((ssp_), (unsigned)(uq_.pm * 256 + (tq_ & 255))); \
    __syncthreads(); } while (0)
__global__ void __launch_bounds__(512, 2) fwd_mega(Args a) {
    extern __shared__ __attribute__((aligned(16))) unsigned char lds_raw[];
    LAS unsigned char* lds = (LAS unsigned char*)lds_raw;
    float* smf = (float*)lds_raw;
    cg::grid_group grid = cg::this_grid();
    const int tid = threadIdx.x, lane = tid & 63, wave = __builtin_amdgcn_readfirstlane(tid >> 6);
    const int G = gridDim.x, bid = blockIdx.x, gw = bid * 8 + wave, NGW = G * 8, gt = bid * 512 + tid, NGT = G * 512;
    const float* x = a.in[0]; const float* c = a.in[1]; const int* pos = (const int*)a.in[2]; const float* w_ada = a.in[3]; const float* b_ada = a.in[4];
    const float* g_mix = a.in[5]; const float* w_in = a.in[6]; const float* g_sgu = a.in[7]; const float* w_sp = a.in[8]; const float* b_sp = a.in[9];
    const float* w_out = a.in[10]; const float* g_ffn = a.in[11]; const float* w_up = a.in[12]; const float* conv_w = a.in[13]; const float* conv_b = a.in[14];
    const float* w_down = a.in[15]; const float* g_final = a.in[16];
    float* out = a.out; unsigned char* ws = a.ws;
    unsigned* ctl = (unsigned*)(ws + WS_CTL);
    float* mod = (float*)(ws + WS_MOD); float* sw1 = (float*)(ws + WS_SW1); float* sw2 = (float*)(ws + WS_SW2); float* ssb = (float*)(ws + WS_SSP);
    float* ct = (float*)(ws + WS_CT); float* st = (float*)(ws + WS_ST); float* lse = (float*)(ws + WS_LSE); float* lastU = (float*)(ws + WS_LASTU); float* firstU = (float*)(ws + WS_FIRSTU);
    bf16_t* ycraw = (bf16_t*)(ws + WS_YC); bf16_t* Wt_in = (bf16_t*)(ws + WS_WIN); bf16_t* Wt_out = (bf16_t*)(ws + WS_WOUT); bf16_t* Wt_up = (bf16_t*)(ws + WS_WUP); bf16_t* Wt_dn = (bf16_t*)(ws + WS_WDN);
    bf16_t* hA = (bf16_t*)(ws + WS_HA); bf16_t* proj = (bf16_t*)(ws + WS_PROJ); bf16_t* ymix = (bf16_t*)(ws + WS_YMIX); bf16_t* gbuf = (bf16_t*)(ws + WS_G);

    unsigned* bcnt = (unsigned*)(ws + WS_CTL) + 64; unsigned epoch = 0u;
    { volatile LAS unsigned* stz = (volatile LAS unsigned*)(lds + RING_BYTES + 2048); if (tid < 2) stz[tid] = 0u; __syncthreads(); }
    const XcdBarrier xbar = xcd_barrier_post((unsigned*)(ws + WS_CTL + 8192), (volatile LAS unsigned*)(lds + RING_BYTES + 2048));
    grid.sync();
    if (bid == 0 && tid < 16) ctl[tid] = 0u;
    for (int i = gt; i < M * 32; i += NGT) { const int r = i >> 5, f = i & 31; const float inv = (float)pow(10000.0, -(double)f / 32.0); const float ang = (float)pos[r] * inv;
        ct[i] = (float)cos((double)ang); st[i] = (float)sin((double)ang); }
    for (int it = bid; it < 4 * 96; it += G) { const int l = it / 96, j0 = (it % 96) * 64;
        const float s = gemv_item<true>(smf, tid, c, D, w_ada + (size_t)l * D * NMOD, NMOD, j0);
        if (tid < 256) { const int b = tid >> 6, j = j0 + (tid & 63); mod[(size_t)(l * 4 + b) * NMOD + j] = s + b_ada[(size_t)l * NMOD + j]; }
        __syncthreads(); }
    { float* scr = smf + wave * 4096;
      for (int it = gw; it < 4 * 6144; it += NGW) { const int l = it / 6144; int r = it % 6144;
          if (r < 1408) { const int kb = r / 88, nb = r % 88; transpose_item(w_in + (size_t)l * D * INW, D, INW, Wt_in + (size_t)l * INW * D, kb * 64, nb * 32, phys_in(nb * 32), scr, lane); continue; } r -= 1408;
          if (r < 512) { const int kb = r / 32, nb = r % 32; transpose_item(w_out + (size_t)l * D * D, D, D, Wt_out + (size_t)l * D * D, kb * 64, nb * 32, nb * 32, scr, lane); continue; } r -= 512;
          if (r < 2816) { const int kb = r / 176, nb = r % 176; transpose_item(w_up + (size_t)l * D * FF2, D, FF2, Wt_up + (size_t)l * FF2 * D, kb * 64, nb * 32, phys_up(nb * 32), scr, lane); continue; } r -= 2816;
          { const int kb = r / 32, nb = r % 32; transpose_item(w_down + (size_t)l * FF * D, FF, D, Wt_dn + (size_t)l * D * FF, kb * 64, nb * 32, nb * 32, scr, lane); } } }
    xcd_barrier(xbar);
    for (int it = bid; it < 4 * 132; it += G) { const int l = it / 132; int r = it % 132;
        if (r < 44) { const int j0 = r * 64; const float s = gemv_item<false>(smf, tid, mod + (size_t)l * 4 * NMOD, NMOD, w_in + (size_t)l * D * INW, INW, j0);
            if (tid < 256) { const int b = tid >> 6, j = j0 + (tid & 63); sw1[(size_t)(l * 4 + b) * INW + phys_in(j & ~31) + (j & 31)] = s; } }
        else { r -= 44; const int j0 = r * 64; const float s = gemv_item<false>(smf, tid, mod + (size_t)l * 4 * NMOD + 3 * D, NMOD, w_up + (size_t)l * D * FF2, FF2, j0);
            if (tid < 256) { const int b = tid >> 6, j = j0 + (tid & 63); sw2[(size_t)(l * 4 + b) * FF2 + phys_up(j & ~31) + (j & 31)] = s; } }
        __syncthreads(); }
    for (int row = gw; row < M; row += NGW) { const int b = row / S; const f32x4* xr = (const f32x4*)(x + (size_t)row * D) + lane; float s2 = 0.f;
#pragma unroll
        for (int j = 0; j < 4; ++j) { const f32x4 v = xr[64 * j]; const int col = 4 * (lane + 64 * j); s2 += (v[0] * v[0] + v[1] * v[1]) + (v[2] * v[2] + v[3] * v[3]);
            const f32x4 gs = *(const f32x4*)(g_mix + col) * (*(const f32x4*)(mod + (size_t)b * NMOD + D + col) + 1.f); const f32x4 o = v * gs;
            u32x2 w; w.x = cvt_pk_bf16(o[0], o[1]); w.y = cvt_pk_bf16(o[2], o[3]); *(u32x2*)(hA + (size_t)row * D + col) = w; }
#pragma unroll
        for (int o = 1; o < 64; o <<= 1) s2 += __shfl_xor(s2, o);
        if (lane < 16) ssb[(size_t)row * 16 + lane] = lane == 0 ? s2 : 0.f; }
    xcd_barrier(xbar);

    for (int l = 0; l < DEPTH; ++l) {
        const float* modl = mod + (size_t)l * 4 * NMOD;
        { pg8::Gemm g{hA, Wt_in + (size_t)l * INW * D, M, INW, D}; pg8::StaticOrder So; So.init(M, INW, G, bid);
          RTAB_BUILD(So, ssb + (size_t)(2 * l) * M * 16);
          EpiIn E{proj, (const LAS float*)(lds + RTAB_OFF), sw1 + (size_t)l * 4 * INW, ct, st};
          pg8::gemm_phase<EpiIn, pg8::StaticOrder, true, true>(lds, g, So, E); }
        xcd_barrier(xbar);
        { int tp = threadIdx.x; asm volatile("" : "+v"(tp));
          volatile unsigned* slot = (volatile unsigned*)(lds_raw + RING_BYTES + 1024);
          if (tp == 0) *slot = atomicAdd(ctl + l, 1u);
          __syncthreads();
          int idx = (int)*slot;
          __syncthreads();
          while (idx < 1280) {
              unsigned nxt = 0u; if (tp == 0) nxt = atomicAdd(ctl + l, 1u);
              if (idx < 384) { const int qb = 15 - idx / 24, bh = idx % 24, b = bh / 6, h = bh % 6;
                  att::unit_sb(lds, proj, b * S, qb * 256, 4 * qb + 3, 512 + h * 64, 896 + h * 64, 1280 + h * 64, ymix, D, 256 + h * 64); }
              else if (idx < 768) { const int j = idx - 384, bh = j % 24, b = bh / 6, h = bh % 6, uidx = j / 24, dil = h < 2 ? 1 : (h < 4 ? 4 : 16), nq = (S / dil) / 256, res = uidx / nq, qb = uidx % nq;
                  att::unit<1>(lds, proj, b * S, res, dil, qb * 256, 4 * qb - 2 < 0 ? 0 : 4 * qb - 2, 4 * qb + 3, 1664 + h * 64, 2048 + h * 64, 2432 + h * 64, ycraw, 384, h * 64, lse, h); }
              else mix_a_unit_mfma(lds_raw, tp, idx - 768, proj, g_sgu + l * 256, w_sp + (size_t)l * 4 * 128 * 128, b_sp + l * 4 * 128, ymix);
              if (tp == 0) *slot = nxt;
              __syncthreads();
              idx = (int)*slot;
              __syncthreads();
          } }
        xcd_barrier(xbar);
        { int tp = threadIdx.x; asm volatile("" : "+v"(tp)); const int lanep = tp & 63, gwp = bid * 8 + (tp >> 6);
          if (lanep < 48) { const int h = lanep >> 3, jj = h & 1;
              for (int row0 = gwp; row0 < M; row0 += 4 * NGW) {
                  float l0[4], l1[4], l2[4]; u32x4 v[4];
#pragma unroll
                  for (int k = 0; k < 4; ++k) { const int row = row0 + k * NGW; if (row < M) { l0[k] = lse[(size_t)row * 6 + jj]; l1[k] = lse[(size_t)row * 6 + 2 + jj]; l2[k] = lse[(size_t)row * 6 + 4 + jj]; v[k] = *(const u32x4*)(ycraw + (size_t)row * 384 + lanep * 8); } }
#pragma unroll
                  for (int k = 0; k < 4; ++k) { const int row = row0 + k * NGW; if (row < M) {
                      const float mm = fmaxf(l0[k], fmaxf(l1[k], l2[k])), e0 = ex2(l0[k] - mm), e1 = ex2(l1[k] - mm), e2 = ex2(l2[k] - mm); const float al = ((h >> 1) == 0 ? e0 : ((h >> 1) == 1 ? e1 : e2)) / (e0 + e1 + e2); u32x4 w;
                      w.x = cvt_pk_bf16(bf_lo(v[k].x) * al, bf_hi(v[k].x) * al); w.y = cvt_pk_bf16(bf_lo(v[k].y) * al, bf_hi(v[k].y) * al); w.z = cvt_pk_bf16(bf_lo(v[k].z) * al, bf_hi(v[k].z) * al); w.w = cvt_pk_bf16(bf_lo(v[k].w) * al, bf_hi(v[k].w) * al);
                      *(u32x4*)(ymix + (size_t)row * D + 640 + lanep * 8) = w; } } } } }
        xcd_barrier(xbar);
        { pg8::StaticOrder So; So.init(M, D, G, bid);
          pg8::Gemm g{ymix, Wt_out + (size_t)l * D * D, M, D, D};
          EpiRes E{l == 0 ? x : out, out, modl + 2 * D, ssb + (size_t)(2 * l + 1) * M * 16, g_ffn + l * D, modl + 4 * D, hA};
          pg8::gemm_phase<EpiRes, pg8::StaticOrder, true, true>(lds, g, So, E); }
        xcd_barrier(xbar);
        { pg8::Gemm g{hA, Wt_up + (size_t)l * FF2 * D, M, FF2, D}; pg8::StaticOrder So; So.init(M, FF2, G, bid);
          RTAB_BUILD(So, ssb + (size_t)(2 * l + 1) * M * 16);
          EpiUc E{gbuf, (const LAS float*)(lds + RTAB_OFF), sw2 + (size_t)l * 4 * FF2, conv_w + (size_t)l * 3 * FF2, conv_b + (size_t)l * FF2, lastU, firstU, proj + (size_t)bid * 131072};
          pg8::gemm_phase<EpiUc, pg8::StaticOrder, true, true>(lds, g, So, E); }
        xcd_barrier(xbar);
        { pg8::StaticOrder So; So.init(M, D, G, bid); Unit u;
          const float* cw = conv_w + (size_t)l * 3 * FF2; const float* cb = conv_b + (size_t)l * FF2;
          int tp = threadIdx.x; asm volatile("" : "+v"(tp));
          for (int i = 0; So.next(i, u); ++i) { if ((u.pm & 15) == 0) continue;
              for (int q = tp; q < FF / 4; q += 512) { const int n = q * 4, pc = (n >> 7) * 256 + (n & 127);
                  const float* f0 = firstU + ((size_t)u.pm * 2) * FF2 + pc; const float* l0 = lastU + ((size_t)(u.pm - 1) * 2) * FF2 + pc;
                  const f32x4 lg0 = *(const f32x4*)l0, lg1 = *(const f32x4*)(l0 + FF2), fg0 = *(const f32x4*)f0, fg1 = *(const f32x4*)(f0 + FF2);
                  const f32x4 lv0 = *(const f32x4*)(l0 + 128), lv1 = *(const f32x4*)(l0 + FF2 + 128), fv0 = *(const f32x4*)(f0 + 128), fv1 = *(const f32x4*)(f0 + FF2 + 128);
                  const f32x4 wg0 = *(const f32x4*)(cw + n), wg1 = *(const f32x4*)(cw + FF2 + n), wg2 = *(const f32x4*)(cw + 2 * FF2 + n), bg = *(const f32x4*)(cb + n);
                  const f32x4 wv0 = *(const f32x4*)(cw + FF + n), wv1 = *(const f32x4*)(cw + FF2 + FF + n), wv2 = *(const f32x4*)(cw + 2 * FF2 + FF + n), bv = *(const f32x4*)(cb + FF + n);
                  const f32x4 og0 = bg + wg0 * lg0 + wg1 * lg1 + wg2 * fg0, ov0 = bv + wv0 * lv0 + wv1 * lv1 + wv2 * fv0;
                  const f32x4 og1 = bg + wg0 * lg1 + wg1 * fg0 + wg2 * fg1, ov1 = bv + wv0 * lv1 + wv1 * fv0 + wv2 * fv1;
                  u32x2 w0_, w1_;
                  w0_.x = cvt_pk_bf16(silu_(og0[0]) * ov0[0], silu_(og0[1]) * ov0[1]); w0_.y = cvt_pk_bf16(silu_(og0[2]) * ov0[2], silu_(og0[3]) * ov0[3]);
                  w1_.x = cvt_pk_bf16(silu_(og1[0]) * ov1[0], silu_(og1[1]) * ov1[1]); w1_.y = cvt_pk_bf16(silu_(og1[2]) * ov1[2], silu_(og1[3]) * ov1[3]);
                  *(u32x2*)(gbuf + (size_t)(u.pm * 256) * FF + n) = w0_; *(u32x2*)(gbuf + (size_t)(u.pm * 256 + 1) * FF + n) = w1_; } }
          asm volatile("s_waitcnt vmcnt(0)" ::: "memory"); __syncthreads();
          pg8::Gemm g{gbuf, Wt_dn + (size_t)l * D * FF, M, D, FF};
          EpiRes E{out, out, modl + 5 * D, ssb + (size_t)(2 * l + 2) * M * 16, l + 1 < DEPTH ? g_mix + (l + 1) * D : nullptr, mod + (size_t)(l + 1 < DEPTH ? l + 1 : l) * 4 * NMOD + D, hA};
          pg8::gemm_phase<EpiRes, pg8::StaticOrder, true, true>(lds, g, So, E); }
        xcd_barrier(xbar);
    }
    int tf = threadIdx.x; asm volatile("" : "+v"(tf)); const int lanef = tf & 63, gwf = bid * 8 + (tf >> 6);
    for (int row = gwf; row < M; row += NGW) { const float r = row_rs(ssb + (size_t)8 * M * 16, (unsigned)row); f32x4* xr = (f32x4*)(out + (size_t)row * D) + lanef;
#pragma unroll
        for (int j = 0; j < 4; ++j) { const int col = 4 * (lanef + 64 * j); xr[64 * j] = xr[64 * j] * r * *(const f32x4*)(g_final + col); } }
}

extern "C" void kernel_launch(void* const* d_in, const int* in_sizes, int n_in, void* d_out, int out_size, void* d_ws, size_t ws_size, hipStream_t stream) {
    static int grid = 0;
    if (grid == 0) {
        if (n_in != 17 || out_size != M * D || ws_size < WS_END) { fprintf(stderr, "kernel_launch: unexpected shapes (n_in %d out %d ws %zu)\n", n_in, out_size, ws_size); grid = -1; return; }
        int dev = 0, cus = 0, per_cu = 0;
        hipGetDevice(&dev); hipDeviceGetAttribute(&cus, hipDeviceAttributeMultiprocessorCount, dev);
        hipFuncSetAttribute((const void*)fwd_mega, hipFuncAttributeMaxDynamicSharedMemorySize, LDS_BYTES);
        hipOccupancyMaxActiveBlocksPerMultiprocessor(&per_cu, (const void*)fwd_mega, 512, LDS_BYTES);
        if (per_cu < 1) per_cu = 1;
        grid = cus * per_cu;
    }
    if (grid < 0) return;
    hipMemsetAsync((char*)d_ws + WS_CTL, 0, 32768, stream);
    Args a{};
    for (int i = 0; i < 17; ++i) a.in[i] = (const float*)d_in[i];
    a.out = (float*)d_out; a.ws = (unsigned char*)d_ws;
    void* args[] = {&a};
    hipError_t e = hipLaunchCooperativeKernel((const void*)fwd_mega, dim3(grid), dim3(512), args, LDS_BYTES, stream);
    if (e != hipSuccess) fprintf(stderr, "cooperative launch failed: %s (grid %d)\n", hipGetErrorString(e), grid);
}
```

```cpp
#include <hip/hip_runtime.h>
#include <hip/hip_cooperative_groups.h>
#include <cstdio>
#include <cstdint>
#include <cmath>
namespace cg = cooperative_groups;
namespace pg8 {
#define PG8_LAS __attribute__((address_space(3)))
typedef unsigned short bf16_t;
typedef short bf16x8 __attribute__((ext_vector_type(8)));
typedef float f32x4 __attribute__((ext_vector_type(4)));
typedef unsigned u32x4 __attribute__((ext_vector_type(4)));
constexpr int BM = 256, BK = 64, HALF = 128, HTB = HALF * BK * 2  , STAGE_BYTES = 8 * HTB, NXCD = 8, WGM = 4;

__host__ __device__ __forceinline__ int lds_byte(int r, int c) { const int st = (r >> 4) * 2 + (c >> 5), rr = r & 15, cc = c & 31, ob = rr * 64 + cc * 2; return st * 1024 + (ob ^ (((ob >> 9) & 1) << 5)); }
__host__ __device__ __forceinline__ void stage_rc(int b, int& R, int& C) { const int st = b / 1024, sb = b % 1024, swz = sb ^ (((sb >> 9) & 1) << 5); R = (st >> 1) * 16 + swz / 64; C = (st & 1) * 32 + (swz % 64) / 2; }
__host__ __device__ __forceinline__ int perm32(int rho) { const int n = rho >> 4, i = rho & 15; return 8 * (i >> 2) + 4 * n + (i & 3); }

struct Unit { int pm, pn; };
struct Gemm { const bf16_t* A; const bf16_t* Bt; int M, N, K; };

struct StaticOrder {
    int nM, nN, nwg, G, c;
    __host__ __device__ void init(int M, int N, int G_, int c_) { nM = M / BM; nN = N / BM; nwg = nM * nN; G = G_; c = c_; }
    __host__ __device__ bool next(int i, Unit& u) const {
        const long L = (long)i * G + c; if (L >= nwg) return false;
        int wgid = (int)L; { const int q = nwg / NXCD, r = nwg % NXCD, xcd = wgid % NXCD, off = wgid / NXCD; wgid = (xcd < r ? xcd * (q + 1) : r * (q + 1) + (xcd - r) * q) + off; }
        const int nig = WGM * nN, gid = wgid / nig, fm = gid * WGM, gsz = (nM - fm) < WGM ? (nM - fm) : WGM;
        u.pm = fm + ((wgid % nig) % gsz); u.pn = (wgid % nig) / gsz; return true;
    }
    __device__ __forceinline__ void a_ready(const Unit&) const {}
    __device__ __forceinline__ void done(const Unit&) const {}
};

template <class Epi, class Sched, bool ALIGN_EPI = false, bool SP2 = false>
__device__ __forceinline__ void gemm_phase(PG8_LAS unsigned char* lds, const Gemm g, const Sched& S, const Epi& E) {
    int tid_l = threadIdx.x; asm volatile("" : "+v"(tid_l));
    const int tid = tid_l, wid = __builtin_amdgcn_readfirstlane(tid >> 6), lane = tid & 63, wr = wid >> 2, wc = wid & 3, fr = lane & 15, fq = lane >> 4;
    const int K = g.K, nt = K / BK;
    unsigned voffA[2], voffB[2];
#pragma unroll
    for (int i = 0; i < 2; ++i) { int R, C; stage_rc(tid * 16 + i * 8192, R, C); const int Rb = Epi::PERM ? ((R & ~31) + perm32(R & 31)) : R;
        voffA[i] = (unsigned)(R * K + C) * 2u; voffB[i] = (unsigned)(Rb * K + C) * 2u; }
    const size_t kstep = (size_t)(BK * 2);
    const size_t hstep = (size_t)HALF * K * 2;
    const size_t tstep = 2 * hstep;
    const unsigned ldsw = (unsigned)wid * 1024u;
    const int aoff = lds_byte(wr * 64 + fr, fq * 8), boff = lds_byte(wc * 32 + fr, fq * 8);
#define PG8_SA(b, h) (((b) * 2 + (h)) * HTB)
#define PG8_SB(b, h) ((4 + (b) * 2 + (h)) * HTB)
#define PG8_STAGE(bufoff, gbase, voff) do { _Pragma("unroll") for (int _i = 0; _i < 2; ++_i) \
        __builtin_amdgcn_global_load_lds((const unsigned*)((const char*)(gbase) + (voff)[_i]), (PG8_LAS unsigned*)(lds + (bufoff) + ldsw + _i * 8192), 16, 0, 0); } while (0)
#define PG8_LDA(dst, b, h) do { _Pragma("unroll") for (int m = 0; m < 4; ++m) _Pragma("unroll") for (int k = 0; k < 2; ++k) dst[m][k] = *(const PG8_LAS bf16x8*)(lds + PG8_SA(b, h) + aoff + m * 2048 + k * 1024); } while (0)
#define PG8_LDB(dst, b, h) do { _Pragma("unroll") for (int n = 0; n < 2; ++n) _Pragma("unroll") for (int k = 0; k < 2; ++k) dst[n][k] = *(const PG8_LAS bf16x8*)(lds + PG8_SB(b, h) + boff + n * 2048 + k * 1024); } while (0)
#define PG8_MMA(ai, bj, At, Bt) do { __builtin_amdgcn_s_setprio(1); _Pragma("unroll") for (int m = 0; m < 4; ++m) _Pragma("unroll") for (int n = 0; n < 2; ++n) _Pragma("unroll") for (int k = 0; k < 2; ++k) \
        acc[ai][bj][m][n] = __builtin_amdgcn_mfma_f32_16x16x32_bf16(Bt[n][k], At[m][k], acc[ai][bj][m][n], 0, 0, 0); __builtin_amdgcn_s_setprio(0); } while (0)
#define PG8_WAIT_V(n) asm volatile("s_waitcnt vmcnt(" #n ")" ::: "memory")
#define PG8_WAIT_L(n) asm volatile("s_waitcnt lgkmcnt(" #n ")" ::: "memory")
#define PG8_BAR __builtin_amdgcn_s_barrier()
#define PG8_SCHED __builtin_amdgcn_sched_barrier(0)
    Unit cur, nxt; int ui = 0;
    if (!S.next(0, cur)) return;
    f32x4 acc[2][2][4][2];
#pragma unroll
    for (int a = 0; a < 2; ++a)
#pragma unroll
        for (int b = 0; b < 2; ++b)
#pragma unroll
            for (int m = 0; m < 4; ++m)
#pragma unroll
                for (int n = 0; n < 2; ++n) acc[a][b][m][n] = (f32x4){0.f, 0.f, 0.f, 0.f};
    bf16x8 At[4][2], B0[2][2], B1[2][2];
    const char* cA = (const char*)g.A + (size_t)cur.pm * tstep; const char* cB = (const char*)g.Bt + (size_t)cur.pn * tstep;
    S.a_ready(cur);
    if constexpr (SP2) {
        PG8_STAGE(PG8_SB(0, 0), cB, voffB); PG8_STAGE(PG8_SB(0, 1), cB + hstep, voffB); PG8_STAGE(PG8_SA(0, 0), cA, voffA); PG8_STAGE(PG8_SA(0, 1), cA + hstep, voffA);
        if (wr == 1) PG8_BAR;
        PG8_WAIT_V(2); PG8_BAR;
        PG8_STAGE(PG8_SB(1, 0), cB + kstep, voffB); PG8_STAGE(PG8_SA(1, 0), cA + kstep, voffA); PG8_STAGE(PG8_SB(1, 1), cB + hstep + kstep, voffB);
        PG8_WAIT_V(6); PG8_BAR;
    } else {
        PG8_STAGE(PG8_SB(0, 0), cB, voffB); PG8_STAGE(PG8_SA(0, 0), cA, voffA); PG8_STAGE(PG8_SB(0, 1), cB + hstep, voffB); PG8_STAGE(PG8_SA(0, 1), cA + hstep, voffA);
        if (wr == 1) PG8_BAR;
        PG8_WAIT_V(4); PG8_BAR;
        PG8_STAGE(PG8_SB(1, 0), cB + kstep, voffB); PG8_STAGE(PG8_SA(1, 0), cA + kstep, voffA); PG8_STAGE(PG8_SB(1, 1), cB + hstep + kstep, voffB);
        PG8_WAIT_V(6); PG8_BAR;
    }
    for (;;) {
        const bool has_next = S.next(ui + 1, nxt);
        const char* nA = has_next ? (const char*)g.A + (size_t)nxt.pm * tstep : cA; const char* nB = has_next ? (const char*)g.Bt + (size_t)nxt.pn * tstep : cB;
        for (int t = 0; t < nt; t += 2) {
            const bool last = (t == nt - 2);
            const char* a1 = cA + (size_t)(t + 1) * kstep;
            const char* a2 = last ? nA : cA + (size_t)(t + 2) * kstep; const char* b2 = last ? nB : cB + (size_t)(t + 2) * kstep;
            const char* a3 = a2 + kstep; const char* b3 = b2 + kstep;
            if (last && has_next) S.a_ready(nxt);
            if constexpr (SP2) {
            PG8_LDB(B0, 0, 0); PG8_LDB(B1, 0, 1); PG8_SCHED; PG8_LDA(At, 0, 0); PG8_STAGE(PG8_SA(1, 1), a1 + hstep, voffA);
            PG8_WAIT_V(8); PG8_WAIT_L(0); PG8_BAR; PG8_MMA(0, 0, At, B0); PG8_MMA(0, 1, At, B1); PG8_BAR; PG8_SCHED;
            PG8_LDA(At, 0, 1); PG8_STAGE(PG8_SB(0, 0), b2, voffB); PG8_STAGE(PG8_SB(0, 1), b2 + hstep, voffB); PG8_STAGE(PG8_SA(0, 0), a2, voffA);
            PG8_WAIT_V(8); PG8_WAIT_L(0); PG8_BAR; PG8_MMA(1, 0, At, B0); PG8_MMA(1, 1, At, B1); PG8_BAR; PG8_SCHED;
            PG8_LDB(B0, 1, 0); PG8_LDB(B1, 1, 1); PG8_SCHED; PG8_LDA(At, 1, 0); PG8_STAGE(PG8_SA(0, 1), a2 + hstep, voffA);
            PG8_WAIT_V(8); PG8_WAIT_L(0); PG8_BAR; PG8_MMA(0, 0, At, B0); PG8_MMA(0, 1, At, B1); PG8_BAR; PG8_SCHED;
            PG8_LDA(At, 1, 1); PG8_STAGE(PG8_SB(1, 0), b3, voffB); PG8_STAGE(PG8_SB(1, 1), b3 + hstep, voffB); PG8_STAGE(PG8_SA(1, 0), a3, voffA);
            PG8_WAIT_V(8); PG8_WAIT_L(0); PG8_BAR; PG8_MMA(1, 0, At, B0); PG8_MMA(1, 1, At, B1); PG8_BAR; PG8_SCHED;
            } else {
            PG8_LDB(B0, 0, 0); PG8_SCHED; PG8_LDA(At, 0, 0); PG8_STAGE(PG8_SA(1, 1), a1 + hstep, voffA);
            PG8_WAIT_L(8); PG8_BAR; PG8_WAIT_L(0); PG8_MMA(0, 0, At, B0); PG8_BAR; PG8_SCHED;
            PG8_LDB(B1, 0, 1); PG8_STAGE(PG8_SB(0, 0), b2, voffB);
            PG8_BAR; PG8_WAIT_L(0); PG8_MMA(0, 1, At, B1); PG8_BAR;
            PG8_LDA(At, 0, 1); PG8_STAGE(PG8_SA(0, 0), a2, voffA);
            PG8_BAR; PG8_WAIT_L(0); PG8_MMA(1, 0, At, B0); PG8_BAR; PG8_SCHED;
            PG8_STAGE(PG8_SB(0, 1), b2 + hstep, voffB);
            PG8_WAIT_V(6); PG8_BAR; PG8_MMA(1, 1, At, B1); PG8_BAR;
            PG8_LDB(B0, 1, 0); PG8_SCHED; PG8_LDA(At, 1, 0); PG8_STAGE(PG8_SA(0, 1), a2 + hstep, voffA);
            PG8_WAIT_L(8); PG8_BAR; PG8_WAIT_L(0); PG8_MMA(0, 0, At, B0); PG8_BAR; PG8_SCHED;
            PG8_LDB(B1, 1, 1); PG8_STAGE(PG8_SB(1, 0), b3, voffB);
            PG8_BAR; PG8_WAIT_L(0); PG8_MMA(0, 1, At, B1); PG8_BAR;
            PG8_LDA(At, 1, 1); PG8_STAGE(PG8_SA(1, 0), a3, voffA);
            PG8_BAR; PG8_WAIT_L(0); PG8_MMA(1, 0, At, B0); PG8_BAR; PG8_SCHED;
            PG8_STAGE(PG8_SB(1, 1), b3 + hstep, voffB);
            PG8_WAIT_V(6); PG8_BAR; PG8_MMA(1, 1, At, B1); PG8_BAR;
            }
        }
        if constexpr (ALIGN_EPI) { if (wr == 0) PG8_BAR; }
        if constexpr (!Epi::AFTER_DRAIN) { E(acc, cur, wr, wc, fr, fq, ui); S.done(cur); }
        if (!has_next) break;
#pragma unroll
        for (int a = 0; a < 2; ++a)
#pragma unroll
            for (int b = 0; b < 2; ++b)
#pragma unroll
                for (int m = 0; m < 4; ++m)
#pragma unroll
                    for (int n = 0; n < 2; ++n) acc[a][b][m][n] = (f32x4){0.f, 0.f, 0.f, 0.f};
        cur = nxt; cA = nA; cB = nB; ++ui;
        if constexpr (ALIGN_EPI) { if (wr == 1) PG8_BAR; }
    }
    PG8_WAIT_V(0);
    if constexpr (!ALIGN_EPI) { if (wr == 0) PG8_BAR; }
    PG8_BAR;
    if constexpr (Epi::AFTER_DRAIN) { E.fused(acc, cur, wr, wc, fr, fq, lds, wid, lane); S.done(cur); }
#undef PG8_SA
#undef PG8_SB
#undef PG8_STAGE
#undef PG8_LDA
#undef PG8_LDB
#undef PG8_MMA
#undef PG8_WAIT_V
#undef PG8_WAIT_L
#undef PG8_BAR
#undef PG8_SCHED
}
}

#ifndef PG8_SP2
#define PG8_SP2 true
#endif
#ifndef PG8_ALIGN
#define PG8_ALIGN true
#endif
constexpr int D = 1024, NB = 4, S = 4096, M = NB * S, DEPTH = 4;
constexpr int INW = 2816, FF = 2816, FF2 = 5632, NMOD = 6144;
constexpr float EPS = 1e-6f;
constexpr float QS = 0.125f * 1.4426950408889634f;
#define LAS __attribute__((address_space(3)))
typedef pg8::bf16_t bf16_t;
typedef pg8::f32x4 f32x4;
typedef pg8::u32x4 u32x4;
typedef unsigned u32x2 __attribute__((ext_vector_type(2)));
using pg8::Unit;

__device__ __forceinline__ unsigned cvt_pk_bf16(float lo, float hi) { unsigned r; asm volatile("v_cvt_pk_bf16_f32 %0, %1, %2" : "=v"(r) : "v"(lo), "v"(hi)); return r; }
__device__ __forceinline__ float bf_lo(unsigned u) { return __uint_as_float(u << 16); }
__device__ __forceinline__ float bf_hi(unsigned u) { return __uint_as_float(u & 0xffff0000u); }
__device__ __forceinline__ float ex2(float x) { return __builtin_amdgcn_exp2f(x); }
__device__ __forceinline__ float lg2(float x) { return __builtin_amdgcn_logf(x); }
__device__ __forceinline__ float rcpf_(float x) { return __builtin_amdgcn_rcpf(x); }
__device__ __forceinline__ float gelu_tanh(float v) { const float u = v + 0.044715f * v * v * v; return v * rcpf_(1.f + ex2(-2.302208199f * u)); }
__device__ __forceinline__ float silu_(float v) { return v * rcpf_(1.f + ex2(-1.4426950409f * v)); }
template <int CTRL> __device__ __forceinline__ float dpp_f(float v) { return __int_as_float(__builtin_amdgcn_update_dpp(0, __float_as_int(v), CTRL, 0xf, 0xf, false)); }
template <int R> __device__ __forceinline__ f32x4 ror4(f32x4 v) { f32x4 r; r[0] = dpp_f<0x120 + R>(v[0]); r[1] = dpp_f<0x120 + R>(v[1]); r[2] = dpp_f<0x120 + R>(v[2]); r[3] = dpp_f<0x120 + R>(v[3]); return r; }

__device__ __forceinline__ float row_rs(const float* ssp, unsigned row) { const f32x4* p = (const f32x4*)((const char*)ssp + row * 64u); const f32x4 a = p[0], b = p[1], c = p[2], d = p[3];
    const f32x4 t = (a + b) + (c + d); return rsqrtf(((t[0] + t[1]) + (t[2] + t[3])) * (1.f / 1024.f) + 1e-6f); }
__device__ __forceinline__ int phys_in(int n0) {
    if (n0 < 512) return n0;
    if (n0 < 1664) return 1280 + (n0 - 512);
    if (n0 < 2432) { const int q = n0 - 1664, hh = q >> 6, half = (q >> 5) & 1; return (2 + (hh >> 2)) * 256 + 128 * half + 32 * (hh & 3); }
    return 1280 + 1152 + (n0 - 2432);
}
__device__ __forceinline__ int phys_up(int n0) { if (n0 < FF) return (n0 >> 7) * 256 + (n0 & 127); const int q = n0 - FF; return (q >> 7) * 256 + 128 + (q & 127); }

constexpr size_t MiB = 1u << 20;
constexpr size_t WS_CTL = 0, WS_MOD = 1 * MiB, WS_SW1 = 2 * MiB, WS_SW2 = 3 * MiB, WS_SS = 4 * MiB, WS_CT = 5 * MiB, WS_ST = 7 * MiB, WS_LSE = 9 * MiB,
                 WS_LASTU = 10 * MiB, WS_FIRSTU = 13 * MiB, WS_YC = 16 * MiB, WS_WIN = 28 * MiB, WS_WOUT = 50 * MiB, WS_WUP = 58 * MiB, WS_WDN = 102 * MiB,
                 WS_HA = 124 * MiB, WS_PROJ = 156 * MiB, WS_YMIX = 244 * MiB, WS_G = 276 * MiB, WS_SSP = 364 * MiB, WS_END = 374 * MiB;
constexpr int RING_BYTES = 131072, HALO_OFF = RING_BYTES, RTAB_OFF = RING_BYTES + 8192, RTAB_UNITS = 16, LDS_BYTES = RTAB_OFF + RTAB_UNITS * 1024;

#define UNPK8(dst, base, v) do { dst[base + 0] = bf_lo(v.x); dst[base + 1] = bf_hi(v.x); dst[base + 2] = bf_lo(v.y); dst[base + 3] = bf_hi(v.y); dst[base + 4] = bf_lo(v.z); dst[base + 5] = bf_hi(v.z); dst[base + 6] = bf_lo(v.w); dst[base + 7] = bf_hi(v.w); } while (0)
struct EpiIn {
    static constexpr bool PERM = true, AFTER_DRAIN = false;
    bf16_t* P; const LAS float* rtab; const float* sw; const float* ct; const float* st;
    __device__ __forceinline__ void operator()(f32x4 (&acc)[2][2][4][2], const Unit& u, int wr, int wc, int fr, int fq, int ui) const {
        { int t_ = threadIdx.x; asm volatile("" : "+v"(t_)); fr = t_ & 15; fq = (t_ >> 4) & 3; }
        const int b = u.pm >> 4; const float* swp = sw + b * INW + u.pn * 256 + wc * 32 + 8 * fq;
        const int row0 = u.pm * 256 + wr * 64 + fr;
        f32x4 sv[2][2];
#pragma unroll
        for (int bj = 0; bj < 2; ++bj)
#pragma unroll
            for (int n = 0; n < 2; ++n) sv[bj][n] = *(const f32x4*)(swp + bj * 128 + 4 * n);
        if (u.pn >= 2 && u.pn <= 4) {
            const int hh = (u.pn - 2) * 4 + wc; const float qs = hh < 6 ? QS : 1.f;
#pragma unroll
            for (int ai = 0; ai < 2; ++ai)
#pragma unroll
                for (int m = 0; m < 4; ++m) { const int row = row0 + ai * 128 + m * 16; const float r = rtab[ui * 256 + (row & 255)];
                    const float* cp = ct + (size_t)row * 32 + 8 * fq; const float* sp = st + (size_t)row * 32 + 8 * fq; u32x4 w1, w2;
#pragma unroll
                    for (int n = 0; n < 2; ++n) { const f32x4 c = *(const f32x4*)(cp + 4 * n), s = *(const f32x4*)(sp + 4 * n);
                        const f32x4 v1 = acc[ai][0][m][n] * r + sv[0][n], v2 = acc[ai][1][m][n] * r + sv[1][n];
                        const f32x4 o1 = (v1 * c - v2 * s) * qs, o2 = (v2 * c + v1 * s) * qs;
                        w1[2 * n] = cvt_pk_bf16(o1[0], o1[1]); w1[2 * n + 1] = cvt_pk_bf16(o1[2], o1[3]); w2[2 * n] = cvt_pk_bf16(o2[0], o2[1]); w2[2 * n + 1] = cvt_pk_bf16(o2[2], o2[3]); }
                    bf16_t* dst = P + (size_t)row * INW + 1664 + hh * 64 + 8 * fq; *(u32x4*)dst = w1; *(u32x4*)(dst + 32) = w2; }
        } else {
            int lc[2]; float sc[2]; const bool gel = u.pn < 2;
#pragma unroll
            for (int bj = 0; bj < 2; ++bj) { if (u.pn < 2) { lc[bj] = u.pn * 256 + bj * 128; sc[bj] = 1.f; }
                else { const int j0 = (u.pn - 5) * 256 + bj * 128; lc[bj] = j0 < 1152 ? 512 + j0 : 2432 + (j0 - 1152); sc[bj] = lc[bj] < 896 ? QS : 1.f; } }
#pragma unroll
            for (int ai = 0; ai < 2; ++ai)
#pragma unroll
                for (int m = 0; m < 4; ++m) { const int row = row0 + ai * 128 + m * 16; const float r = rtab[ui * 256 + (row & 255)];
#pragma unroll
                    for (int bj = 0; bj < 2; ++bj) { f32x4 v0 = acc[ai][bj][m][0] * r + sv[bj][0], v1 = acc[ai][bj][m][1] * r + sv[bj][1];
                        if (gel) {
#pragma unroll
                            for (int e = 0; e < 4; ++e) { v0[e] = gelu_tanh(v0[e]); v1[e] = gelu_tanh(v1[e]); } }
                        else { v0 = v0 * sc[bj]; v1 = v1 * sc[bj]; }
                        u32x4 w; w.x = cvt_pk_bf16(v0[0], v0[1]); w.y = cvt_pk_bf16(v0[2], v0[3]); w.z = cvt_pk_bf16(v1[0], v1[1]); w.w = cvt_pk_bf16(v1[2], v1[3]);
                        *(u32x4*)(P + (size_t)row * INW + lc[bj] + wc * 32 + 8 * fq) = w; } }
        }
    }
};
struct EpiRes {
    static constexpr bool PERM = false, AFTER_DRAIN = false;
    const float* xin; float* xout; const float* gate; float* ssout; const float* gnext; const float* scnext; bf16_t* xs;
    __device__ __forceinline__ void operator()(f32x4 (&acc)[2][2][4][2], const Unit& u, int wr, int wc, int fr, int fq, int ui) const {
        { int t_ = threadIdx.x; asm volatile("" : "+v"(t_)); fr = t_ & 15; fq = (t_ >> 4) & 3; }
        const int b = u.pm >> 4, col0 = u.pn * 256 + wc * 32 + 4 * fq;
        f32x4 gt[2][2], gs[2][2];
#pragma unroll
        for (int bj = 0; bj < 2; ++bj)
#pragma unroll
            for (int n = 0; n < 2; ++n) { const int col = col0 + bj * 128 + n * 16; gt[bj][n] = *(const f32x4*)(gate + b * NMOD + col) + 1.f;
                gs[bj][n] = gnext ? *(const f32x4*)(gnext + col) * (*(const f32x4*)(scnext + b * NMOD + col) + 1.f) : (f32x4){0.f, 0.f, 0.f, 0.f}; }
#pragma unroll
        for (int am = 0; am < 4; ++am) { const int ai = am >> 1, mb = (am & 1) * 2;
            f32x4 pre[2][2][2];
#pragma unroll
            for (int mm = 0; mm < 2; ++mm) { const size_t rb = (size_t)(u.pm * 256 + ai * 128 + wr * 64 + (mb + mm) * 16 + fr) * D + col0;
#pragma unroll
                for (int bj = 0; bj < 2; ++bj)
#pragma unroll
                    for (int n = 0; n < 2; ++n) pre[mm][bj][n] = *(const f32x4*)(xin + rb + bj * 128 + n * 16); }
#pragma unroll
            for (int mm = 0; mm < 2; ++mm) { const int m = mb + mm; const int row = u.pm * 256 + ai * 128 + wr * 64 + m * 16 + fr; float q = 0.f;
#pragma unroll
                for (int bj = 0; bj < 2; ++bj)
#pragma unroll
                    for (int n = 0; n < 2; ++n) { const size_t off = (size_t)row * D + col0 + bj * 128 + n * 16;
                        const f32x4 xn = pre[mm][bj][n] + gt[bj][n] * acc[ai][bj][m][n]; *(f32x4*)(xout + off) = xn;
                        q += (xn[0] * xn[0] + xn[1] * xn[1]) + (xn[2] * xn[2] + xn[3] * xn[3]);
                        if (gnext) { const f32x4 o = xn * gs[bj][n]; u32x2 w; w.x = cvt_pk_bf16(o[0], o[1]); w.y = cvt_pk_bf16(o[2], o[3]); *(u32x2*)(xs + off) = w; } }
                q += __shfl_xor(q, 16); q += __shfl_xor(q, 32);
                if (fq == 0) ssout[(size_t)row * 16 + u.pn * 4 + wc] = q; } }
    }
};
struct EpiU {
    static constexpr bool PERM = true, AFTER_DRAIN = false;
    bf16_t* U; const float* ss; const float* sw; int rowoff;
    __device__ __forceinline__ void operator()(f32x4 (&acc)[2][2][4][2], const Unit& u, int wr, int wc, int fr, int fq, int ui) const {
        { int t_ = threadIdx.x; asm volatile("" : "+v"(t_)); fr = t_ & 15; fq = (t_ >> 4) & 3; }
        const int b = (rowoff >> 12) + (u.pm >> 4), cl = wc * 32 + 8 * fq;
        const unsigned rowl = (unsigned)(u.pm * 256 + wr * 64 + fr);
        f32x4 sv[2][2];
        const char* swb = (const char*)sw + (unsigned)(b * FF2 + u.pn * 256 + cl) * 4u;
#pragma unroll
        for (int bj = 0; bj < 2; ++bj)
#pragma unroll
            for (int n = 0; n < 2; ++n) sv[bj][n] = *(const f32x4*)(swb + (bj * 128 + 4 * n) * 4);
        char* up = (char*)U + (rowl * (unsigned)FF2 + (unsigned)(u.pn * 128 + cl)) * 2u;
#pragma unroll
        for (int ai = 0; ai < 2; ++ai)
#pragma unroll
            for (int m = 0; m < 4; ++m) { const float r = row_rs(ss, (unsigned)rowoff + rowl + ai * 128 + m * 16);
#pragma unroll
                for (int bj = 0; bj < 2; ++bj) { const f32x4 v0 = acc[ai][bj][m][0] * r + sv[bj][0], v1 = acc[ai][bj][m][1] * r + sv[bj][1];
                    u32x4 w; w.x = cvt_pk_bf16(v0[0], v0[1]); w.y = cvt_pk_bf16(v0[2], v0[3]); w.z = cvt_pk_bf16(v1[0], v1[1]); w.w = cvt_pk_bf16(v1[2], v1[3]);
                    *(u32x4*)(up + (unsigned)((ai * 128 + m * 16) * FF2 + bj * FF) * 2u) = w; } }
    }
};
__device__ __forceinline__ u32x4 ld16_agent(const bf16_t* p) { const unsigned long long a = __hip_atomic_load((const unsigned long long*)p, __ATOMIC_RELAXED, __HIP_MEMORY_SCOPE_AGENT), b = __hip_atomic_load((const unsigned long long*)p + 1, __ATOMIC_RELAXED, __HIP_MEMORY_SCOPE_AGENT);
    u32x4 r; r.x = (unsigned)a; r.y = (unsigned)(a >> 32); r.z = (unsigned)b; r.w = (unsigned)(b >> 32); return r; }
struct EpiUc {
    static constexpr bool PERM = true, AFTER_DRAIN = false;
    bf16_t* Gout; const LAS float* rtab; const float* sw; const float* cw; const float* cb; float* lastU; float* firstU; bf16_t* scr2;
    __device__ __forceinline__ void operator()(f32x4 (&acc)[2][2][4][2], const Unit& u, int wr, int wc, int fr, int fq, int ui) const {
        int t_ = threadIdx.x; asm volatile("" : "+v"(t_)); fr = t_ & 15; fq = (t_ >> 4) & 3;
        const int b = u.pm >> 4, cl = wc * 32 + 8 * fq;
        const unsigned rowl = (unsigned)(wr * 64 + fr);
        bf16_t* const scr = scr2 + (size_t)(ui & 1) * 65536;
        { float rr[2][4];
#pragma unroll
          for (int ai = 0; ai < 2; ++ai)
#pragma unroll
              for (int m = 0; m < 4; ++m) rr[ai][m] = rtab[ui * 256 + rowl + ai * 128 + m * 16];
          const unsigned so = (unsigned)(b * FF2 + u.pn * 256 + cl) * 4u;
#pragma unroll
          for (int bj = 0; bj < 2; ++bj) { const f32x4 sv0 = *(const f32x4*)((const char*)sw + (so + (unsigned)(bj * 512))), sv1 = *(const f32x4*)((const char*)sw + (so + (unsigned)(bj * 512 + 16)));
#pragma unroll
              for (int ai = 0; ai < 2; ++ai)
#pragma unroll
                  for (int m = 0; m < 4; ++m) { const f32x4 v0 = acc[ai][bj][m][0] * rr[ai][m] + sv0, v1 = acc[ai][bj][m][1] * rr[ai][m] + sv1;
                      u32x4 w; w.x = cvt_pk_bf16(v0[0], v0[1]); w.y = cvt_pk_bf16(v0[2], v0[3]); w.z = cvt_pk_bf16(v1[0], v1[1]); w.w = cvt_pk_bf16(v1[2], v1[3]);
                      *(u32x4*)((char*)scr + ((rowl + ai * 128 + m * 16) * 256u + (unsigned)(bj * 128 + cl)) * 2u) = w;
                      if (m == 3 && ai == 1 && wr == 1 && fr >= 14) { float* lp = lastU + ((size_t)u.pm * 2 + (fr - 14)) * FF2 + u.pn * 256 + bj * 128 + cl; *(f32x4*)lp = v0; *(f32x4*)(lp + 4) = v1; }
                      if (m == 0 && ai == 0 && wr == 0 && fr < 2) { float* fp = firstU + ((size_t)u.pm * 2 + fr) * FF2 + u.pn * 256 + bj * 128 + cl; *(f32x4*)fp = v0; *(f32x4*)(fp + 4) = v1; } } } }
        asm volatile("s_waitcnt vmcnt(0)" ::: "memory"); __builtin_amdgcn_s_barrier();
        { const int cgp = t_ & 15, r0 = (t_ >> 4) * 8, gcol = u.pn * 128 + cgp * 8;
          float wg[3][8], wv[3][8], bg[8], bv[8];
#pragma unroll
          for (int k = 0; k < 3; ++k)
#pragma unroll
              for (int e = 0; e < 8; e += 4) { const f32x4 a = *(const f32x4*)(cw + k * FF2 + gcol + e), c2 = *(const f32x4*)(cw + k * FF2 + FF + gcol + e);
#pragma unroll
                  for (int q = 0; q < 4; ++q) { wg[k][e + q] = a[q]; wv[k][e + q] = c2[q]; } }
#pragma unroll
          for (int e = 0; e < 8; e += 4) { const f32x4 a = *(const f32x4*)(cb + gcol + e), c2 = *(const f32x4*)(cb + FF + gcol + e);
#pragma unroll
              for (int q = 0; q < 4; ++q) { bg[e + q] = a[q]; bv[e + q] = c2[q]; } }
          const bf16_t* sp = scr + (size_t)r0 * 256 + cgp * 8;
          u32x4 ua[10], uc[10];
          if (r0 > 0) { ua[0] = ld16_agent(sp - 512); uc[0] = ld16_agent(sp - 512 + 128); ua[1] = ld16_agent(sp - 256); uc[1] = ld16_agent(sp - 256 + 128); }
          else { ua[0] = (u32x4){0u, 0u, 0u, 0u}; uc[0] = ua[0]; ua[1] = ua[0]; uc[1] = ua[0]; }
#pragma unroll
          for (int k = 0; k < 8; ++k) { ua[2 + k] = ld16_agent(sp + k * 256); uc[2 + k] = ld16_agent(sp + k * 256 + 128); }
          float g2[8], g1[8], v2[8], v1_[8];
          UNPK8(g2, 0, ua[0]); UNPK8(v2, 0, uc[0]); UNPK8(g1, 0, ua[1]); UNPK8(v1_, 0, uc[1]);
#pragma unroll
          for (int k = 0; k < 8; ++k) {
              float g0[8], v0[8]; UNPK8(g0, 0, ua[2 + k]); UNPK8(v0, 0, uc[2 + k]);
              float res[8];
#pragma unroll
              for (int e = 0; e < 8; ++e) { const float og = bg[e] + wg[0][e] * g2[e] + wg[1][e] * g1[e] + wg[2][e] * g0[e], ov = bv[e] + wv[0][e] * v2[e] + wv[1][e] * v1_[e] + wv[2][e] * v0[e];
                  res[e] = silu_(og) * ov; g2[e] = g1[e]; g1[e] = g0[e]; v2[e] = v1_[e]; v1_[e] = v0[e]; }
              u32x4 w; w.x = cvt_pk_bf16(res[0], res[1]); w.y = cvt_pk_bf16(res[2], res[3]); w.z = cvt_pk_bf16(res[4], res[5]); w.w = cvt_pk_bf16(res[6], res[7]);
              *(u32x4*)(Gout + (size_t)(u.pm * 256 + r0 + k) * FF + gcol) = w; } }
    }
};
struct Args { const float* in[17]; float* out; unsigned char* ws; };

#define XB_TMO      128
#define XB_XCNT(j)  (256  + 64 * (j))
#define XB_XSUB(j)  (1280 + 64 * (j))
#define XB_XGEN(j)  (2304 + 64 * (j))
#define XB_TOP      3328
#define XB_TOPGEN   3392
#define XCD_BAR_WORDS 3456
#define XB_SPIN_CAP (1u << 18)

__device__ __forceinline__ unsigned xb_ld(unsigned* p)              { return __hip_atomic_load(p, __ATOMIC_RELAXED, __HIP_MEMORY_SCOPE_AGENT); }
__device__ __forceinline__ unsigned xb_add(unsigned* p, unsigned v) { return __hip_atomic_fetch_add(p, v, __ATOMIC_RELAXED, __HIP_MEMORY_SCOPE_AGENT); }
__device__ __forceinline__ unsigned xb_xcc_id() { return (unsigned)__builtin_amdgcn_s_getreg((3 << 11) | 20) & 0xFu; }
#define XB_SPIN(cond, bar) do { unsigned _sp = 0; while (cond) { __builtin_amdgcn_s_sleep(1); \
    if ((++_sp & 255u) == 0u) { if (xb_ld(&(bar)[XB_TMO])) break; if (_sp > XB_SPIN_CAP) { atomicAdd(&(bar)[XB_TMO], 1u); break; } } } } while (0)

struct XcdBarrier {
    unsigned* bar; unsigned x;
    volatile LAS unsigned* st;
};

__device__ __forceinline__ XcdBarrier xcd_barrier_post(unsigned* bar, volatile LAS unsigned* st) {
    XcdBarrier b; b.bar = bar; b.x = xb_xcc_id(); b.st = st;
    if (threadIdx.x == 0) (void)xb_add(&bar[XB_XCNT(b.x)], 1u);
    return b;
}
__device__ __forceinline__ void xcd_barrier_complete(unsigned* bar, unsigned x, unsigned& nloc, unsigned& nx) {
    const unsigned G = gridDim.x * gridDim.y * gridDim.z;
    unsigned sum, cnt, mine, sp = 0u;
    for (;;) {
        sum = 0u; cnt = 0u; mine = 0u;
#pragma unroll
        for (unsigned j = 0; j < 16; ++j) { const unsigned c = xb_ld(&bar[XB_XCNT(j)]); sum += c; cnt += (c > 0u) ? 1u : 0u; mine = (j == x) ? c : mine; }
        if (sum == G) break;
        __builtin_amdgcn_s_sleep(1);
        if ((++sp & 255u) == 0u) { if (xb_ld(&bar[XB_TMO])) break; if (sp > XB_SPIN_CAP) { atomicAdd(&bar[XB_TMO], 1u); break; } }
    }
    nloc = mine > 0u ? mine : 1u; nx = cnt > 0u ? cnt : 1u;
}

__device__ __forceinline__ void xcd_barrier(const XcdBarrier& b_in) {
    XcdBarrier b = b_in; b.x = (unsigned)__builtin_amdgcn_readfirstlane((int)xb_xcc_id());
    asm volatile("s_waitcnt vmcnt(0)" ::: "memory");
    __syncthreads();
    if (threadIdx.x == 0) {
        unsigned* bar = b.bar;
        __builtin_amdgcn_s_waitcnt(0);
        unsigned nloc = b.st[0], nx = b.st[1];
        if (nloc == 0u) { xcd_barrier_complete(bar, b.x, nloc, nx); b.st[0] = nloc; b.st[1] = nx; }
        const unsigned old = xb_add(&bar[XB_XSUB(b.x)], 1u);
        const unsigned gen = old / nloc;
        if (old + 1u == (gen + 1u) * nloc) {
            __builtin_amdgcn_fence(__ATOMIC_RELEASE, "agent");
            asm volatile("s_waitcnt vmcnt(0)" ::: "memory");
            const unsigned og = xb_add(&bar[XB_TOP], 1u);
            const unsigned tg = og / nx;
            if (og + 1u == (tg + 1u) * nx) xb_add(&bar[XB_TOPGEN], 1u);
            else XB_SPIN(xb_ld(&bar[XB_TOPGEN]) == tg, bar);
            __builtin_amdgcn_fence(__ATOMIC_ACQUIRE, "agent");
            xb_add(&bar[XB_XGEN(b.x)], 1u);
            asm volatile("s_waitcnt vmcnt(0)" ::: "memory");
        } else {
            XB_SPIN(xb_ld(&bar[XB_XGEN(b.x)]) == gen, bar);
            __builtin_amdgcn_fence(__ATOMIC_ACQUIRE, "agent");
            asm volatile("s_waitcnt vmcnt(0)" ::: "memory");
        }
    }
    __syncthreads();
}

__device__ __forceinline__ void gbar(unsigned* cnt, unsigned& epoch) {
    asm volatile("s_waitcnt vmcnt(0)" ::: "memory");
    __syncthreads();
    epoch += gridDim.x;
    if (threadIdx.x == 0) {
        __builtin_amdgcn_fence(__ATOMIC_RELEASE, "agent");
        asm volatile("s_waitcnt vmcnt(0)" ::: "memory");
        __hip_atomic_fetch_add(cnt, 1u, __ATOMIC_RELAXED, __HIP_MEMORY_SCOPE_AGENT);
        while (__hip_atomic_load(cnt, __ATOMIC_RELAXED, __HIP_MEMORY_SCOPE_AGENT) < epoch) __builtin_amdgcn_s_sleep(1);
        __builtin_amdgcn_fence(__ATOMIC_ACQUIRE, "agent");
        asm volatile("s_waitcnt vmcnt(0)" ::: "memory");
    }
    __syncthreads();
}


template <bool SILU> __device__ __forceinline__ float gemv_item(float* sm, int tid, const float* vsrc, int vstride, const float* W, int N, int j0) {
    const int lane = tid & 63, w = tid >> 6;
    for (int i = tid; i < 4096; i += 512) { const int b = i >> 10, k = i & 1023; const float v = vsrc[(size_t)b * vstride + k]; sm[i] = SILU ? v / (1.f + expf(-v)) : v; }
    __syncthreads();
    float a0 = 0.f, a1 = 0.f, a2 = 0.f, a3 = 0.f;
    const float* wp = W + (size_t)(128 * w) * N + j0 + lane;
#pragma unroll 8
    for (int k = 0; k < 128; ++k) { const float wv = wp[(size_t)k * N]; const int kk = 128 * w + k; a0 += sm[kk] * wv; a1 += sm[1024 + kk] * wv; a2 += sm[2048 + kk] * wv; a3 += sm[3072 + kk] * wv; }
    float* red = sm + 4096;
    red[(w * 4 + 0) * 64 + lane] = a0; red[(w * 4 + 1) * 64 + lane] = a1; red[(w * 4 + 2) * 64 + lane] = a2; red[(w * 4 + 3) * 64 + lane] = a3;
    __syncthreads();
    float s = 0.f;
    if (tid < 256) { const int b = tid >> 6;
#pragma unroll
        for (int ww = 0; ww < 8; ++ww) s += red[(ww * 4 + b) * 64 + lane]; }
    return s;
}
__device__ __forceinline__ void transpose_item(const float* W, int K, int N, bf16_t* WT, int k0, int n0, int prow0, float* scr, int lane) {
#pragma unroll 8
    for (int i = 0; i < 32; ++i) { const int kk = 2 * i + (lane >> 5); scr[kk * 33 + (lane & 31)] = W[(size_t)(k0 + kk) * N + n0 + (lane & 31)]; }
    asm volatile("s_waitcnt lgkmcnt(0)" ::: "memory");
    const int c = lane & 7;
#pragma unroll
    for (int j = 0; j < 4; ++j) { const int n = (lane >> 3) + 8 * j; const float* s = scr + (8 * c) * 33 + n;
        u32x4 o; o.x = cvt_pk_bf16(s[0 * 33], s[1 * 33]); o.y = cvt_pk_bf16(s[2 * 33], s[3 * 33]); o.z = cvt_pk_bf16(s[4 * 33], s[5 * 33]); o.w = cvt_pk_bf16(s[6 * 33], s[7 * 33]);
        *(u32x4*)(WT + (size_t)(prow0 + n) * K + k0 + 8 * c) = o; }
    asm volatile("s_waitcnt lgkmcnt(0)" ::: "memory");
}

__device__ __forceinline__ void mix_a_unit(float* sm, int tid, int unit, const bf16_t* proj, const float* g_sgu, const float* w_sp, const float* b_sp, bf16_t* ymix) {
    float* w = sm; float* vn = sm + 128 * 128;
    const int g = unit & 3, ch = (unit >> 2) & 31, b = unit >> 7; const size_t row0 = (size_t)b * S + ch * 128;
    for (int i = tid; i < 128 * 128; i += 512) { const int t = i >> 7, s = i & 127; w[i] = (s <= t) ? w_sp[(size_t)g * 128 * 128 + i] : 0.f; }
    { const int r = tid >> 2, c0 = (tid & 3) * 16; float v[16]; float ss = 0.f;
      const u32x4* p = (const u32x4*)(proj + (row0 + r) * INW + 256 + g * 64 + c0); const u32x4 v0 = p[0], v1 = p[1];
      UNPK8(v, 0, v0); UNPK8(v, 8, v1);
#pragma unroll
      for (int j = 0; j < 16; ++j) ss += v[j] * v[j];
      ss += __shfl_xor(ss, 1); ss += __shfl_xor(ss, 2);
      const float rr = rsqrtf(ss * (1.f / 64.f) + EPS);
#pragma unroll
      for (int j = 0; j < 16; ++j) vn[r * 64 + c0 + j] = v[j] * rr * g_sgu[g * 64 + c0 + j]; }
    __syncthreads();
    const int tq = tid >> 4, cq = tid & 15;
    float acc[4][4];
#pragma unroll
    for (int i = 0; i < 4; ++i)
#pragma unroll
        for (int j = 0; j < 4; ++j) acc[i][j] = 0.f;
    for (int s = 0; s <= 4 * tq + 3; ++s) { const f32x4 vv = *(const f32x4*)&vn[s * 64 + 4 * cq];
#pragma unroll
        for (int i = 0; i < 4; ++i) { const float wv = w[(4 * tq + i) * 128 + s]; acc[i][0] += wv * vv[0]; acc[i][1] += wv * vv[1]; acc[i][2] += wv * vv[2]; acc[i][3] += wv * vv[3]; } }
#pragma unroll
    for (int i = 0; i < 4; ++i) { const int t = 4 * tq + i; const float bb = b_sp[g * 128 + t];
        const u32x2 uu = *(const u32x2*)(proj + (row0 + t) * INW + g * 64 + 4 * cq);
        u32x2 o; o.x = cvt_pk_bf16(bf_lo(uu.x) * (acc[i][0] + bb), bf_hi(uu.x) * (acc[i][1] + bb)); o.y = cvt_pk_bf16(bf_lo(uu.y) * (acc[i][2] + bb), bf_hi(uu.y) * (acc[i][3] + bb));
        *(u32x2*)(ymix + (row0 + t) * D + g * 64 + 4 * cq) = o; }
    __syncthreads();
}
__device__ __forceinline__ void mix_a_unit_mfma(unsigned char* smb, int tid, int unit, const bf16_t* proj, const float* g_sgu, const float* w_sp, const float* b_sp, bf16_t* ymix) {
    constexpr int VS = 136;
    bf16_t* vnT = (bf16_t*)smb;
    const int g = unit & 3, ch = (unit >> 2) & 31, b = unit >> 7, lane = tid & 63, wv = tid >> 6; const size_t row0 = (size_t)b * S + ch * 128;
    { const int r = tid >> 2, c0 = (tid & 3) * 16; float v[16]; float ss = 0.f;
      const u32x4* p = (const u32x4*)(proj + (row0 + r) * INW + 256 + g * 64 + c0); const u32x4 v0 = p[0], v1 = p[1];
      UNPK8(v, 0, v0); UNPK8(v, 8, v1);
#pragma unroll
      for (int j = 0; j < 16; ++j) ss += v[j] * v[j];
      ss += __shfl_xor(ss, 1); ss += __shfl_xor(ss, 2);
      const float rr = rsqrtf(ss * (1.f / 64.f) + EPS);
#pragma unroll
      for (int j = 0; j < 16; j += 2) { const unsigned pk = cvt_pk_bf16(v[j] * rr * g_sgu[g * 64 + c0 + j], v[j + 1] * rr * g_sgu[g * 64 + c0 + j + 1]);
          vnT[(c0 + j) * VS + r] = (bf16_t)(pk & 0xffffu); vnT[(c0 + j + 1) * VS + r] = (bf16_t)(pk >> 16); } }
    __syncthreads();
    const int tr = lane & 15, quad = lane >> 4, t0 = 16 * wv;
    f32x4 acc[4];
#pragma unroll
    for (int ct = 0; ct < 4; ++ct) acc[ct] = (f32x4){0.f, 0.f, 0.f, 0.f};
    const float* wrow = w_sp + ((size_t)g * 128 + t0 + tr) * 128;
    const int nks = (t0 + 15) / 32 + 1;
    for (int ks = 0; ks < nks; ++ks) { const int s0 = 32 * ks + 8 * quad; const f32x4 a0 = *(const f32x4*)(wrow + s0), a1 = *(const f32x4*)(wrow + s0 + 4);
        float aw[8] = {a0[0], a0[1], a0[2], a0[3], a1[0], a1[1], a1[2], a1[3]};
#pragma unroll
        for (int j = 0; j < 8; ++j) if (s0 + j > t0 + tr) aw[j] = 0.f;
        u32x4 ap; ap.x = cvt_pk_bf16(aw[0], aw[1]); ap.y = cvt_pk_bf16(aw[2], aw[3]); ap.z = cvt_pk_bf16(aw[4], aw[5]); ap.w = cvt_pk_bf16(aw[6], aw[7]);
        const pg8::bf16x8 af = __builtin_bit_cast(pg8::bf16x8, ap);
#pragma unroll
        for (int ct = 0; ct < 4; ++ct) { const pg8::bf16x8 bfr = *(const pg8::bf16x8*)(vnT + (16 * ct + tr) * VS + s0);
            acc[ct] = __builtin_amdgcn_mfma_f32_16x16x32_bf16(af, bfr, acc[ct], 0, 0, 0); } }
#pragma unroll
    for (int j = 0; j < 4; ++j) { const int t = t0 + quad * 4 + j; const float bb = b_sp[g * 128 + t];
#pragma unroll
        for (int ct = 0; ct < 4; ++ct) { const int c = g * 64 + 16 * ct + tr; const float u = bf_lo((unsigned)proj[(row0 + t) * INW + c]);
            const unsigned pk = cvt_pk_bf16(u * (acc[ct][j] + bb), 0.f); ymix[(row0 + t) * D + c] = (bf16_t)(pk & 0xffffu); } }
    __syncthreads();
}
__device__ __forceinline__ void mix_b_naive(int item, int lane, const bf16_t* proj, bf16_t* ymix) {
    const int qb = 63 - item / 24, bh = item % 24, b = bh / 6, h = bh % 6, t = qb * 64 + lane; const size_t rb = (size_t)b * S;
    float q[64], o[64];
    { const u32x4* p = (const u32x4*)(proj + (rb + t) * INW + 512 + h * 64);
#pragma unroll
      for (int c = 0; c < 8; ++c) { const u32x4 v = p[c]; UNPK8(q, 8 * c, v); } }
#pragma unroll
    for (int d = 0; d < 64; ++d) o[d] = 0.f;
    float C = 0.f;
    for (int s = qb * 64 + 62; s >= 0; --s) {
        const u32x4* kp = (const u32x4*)(proj + (rb + s) * INW + 896 + h * 64); const u32x4* vp = (const u32x4*)(proj + (rb + s) * INW + 1280 + h * 64);
        float z = 0.f;
#pragma unroll
        for (int c = 0; c < 8; ++c) { const u32x4 v = kp[c]; float kk[8]; UNPK8(kk, 0, v);
#pragma unroll
            for (int e = 0; e < 8; ++e) z += q[8 * c + e] * kk[e]; }
        float wgt = 0.f;
        if (s < t) { z = fminf(z, 100.f); const float sp = lg2(1.f + ex2(z)); C += sp; wgt = ex2(z - C); }
#pragma unroll
        for (int c = 0; c < 8; ++c) { const u32x4 v = vp[c]; float vv[8]; UNPK8(vv, 0, v);
#pragma unroll
            for (int e = 0; e < 8; ++e) o[8 * c + e] += wgt * vv[e]; }
    }
    u32x4* op = (u32x4*)(ymix + (rb + t) * D + 256 + h * 64);
#pragma unroll
    for (int c = 0; c < 8; ++c) { u32x4 w; w.x = cvt_pk_bf16(o[8 * c], o[8 * c + 1]); w.y = cvt_pk_bf16(o[8 * c + 2], o[8 * c + 3]); w.z = cvt_pk_bf16(o[8 * c + 4], o[8 * c + 5]); w.w = cvt_pk_bf16(o[8 * c + 6], o[8 * c + 7]); op[c] = w; }
}
__device__ __forceinline__ void mix_c_naive(int item, int lane, const bf16_t* proj, bf16_t* ycraw, float* lse) {
    const int h = item % 6, row = (item / 6) * 64 + lane, b = row / S, t = row % S, dil = (h < 2) ? 1 : (h < 4 ? 4 : 16);
    float q[64], o[64];
    { const u32x4* p = (const u32x4*)(proj + (size_t)row * INW + 1664 + h * 64);
#pragma unroll
      for (int c = 0; c < 8; ++c) { const u32x4 v = p[c]; UNPK8(q, 8 * c, v); } }
#pragma unroll
    for (int d = 0; d < 64; ++d) o[d] = 0.f;
    float mx = -INFINITY, l = 0.f;
    for (int m = 0; m <= 128; ++m) { const int idx = t - m * dil; const bool valid = idx >= 0; const int ic = idx < 0 ? 0 : idx;
        const u32x4* kp = (const u32x4*)(proj + ((size_t)b * S + ic) * INW + 2048 + h * 64); const u32x4* vp = (const u32x4*)(proj + ((size_t)b * S + ic) * INW + 2432 + h * 64);
        float z = 0.f;
#pragma unroll
        for (int c = 0; c < 8; ++c) { const u32x4 v = kp[c]; float kk[8]; UNPK8(kk, 0, v);
#pragma unroll
            for (int e = 0; e < 8; ++e) z += q[8 * c + e] * kk[e]; }
        float f = 1.f, p = 0.f;
        if (valid) { const float mn = fmaxf(mx, z); f = ex2(mx - mn); p = ex2(z - mn); mx = mn; }
        l = l * f + p;
#pragma unroll
        for (int c = 0; c < 8; ++c) { const u32x4 v = vp[c]; float vv[8]; UNPK8(vv, 0, v);
#pragma unroll
            for (int e = 0; e < 8; ++e) o[8 * c + e] = o[8 * c + e] * f + p * vv[e]; }
    }
    const float il = 1.f / l;
    u32x4* op = (u32x4*)(ycraw + (size_t)row * 384 + h * 64);
#pragma unroll
    for (int c = 0; c < 8; ++c) { u32x4 w; w.x = cvt_pk_bf16(o[8 * c] * il, o[8 * c + 1] * il); w.y = cvt_pk_bf16(o[8 * c + 2] * il, o[8 * c + 3] * il); w.z = cvt_pk_bf16(o[8 * c + 4] * il, o[8 * c + 5] * il); w.w = cvt_pk_bf16(o[8 * c + 6] * il, o[8 * c + 7] * il); op[c] = w; }
    lse[(size_t)row * 6 + h] = mx + lg2(l);
}
namespace att {
typedef short bf16x8 __attribute__((ext_vector_type(8)));
typedef short s16x4 __attribute__((ext_vector_type(4)));
typedef float f32x16 __attribute__((ext_vector_type(16)));
constexpr int SLOTB = 8192, LDS_K = 0, LDS_V = 3 * SLOTB, LDS_WS = 6 * SLOTB, LDS_OST = LDS_WS + 8 * 64 * 4, LDS_TOT = LDS_OST + 8 * 4096;
__device__ __forceinline__ int crow(int r, int hi) { return (r & 3) + 8 * (r >> 2) + 4 * hi; }
__device__ __forceinline__ void glds16(const void* gsrc, unsigned lds_dst) { unsigned keep;
    asm volatile("s_mov_b32 %0, m0\n\ts_mov_b32 m0, %2\n\ts_nop 0\n\tglobal_load_lds_dwordx4 %1, off\n\ts_mov_b32 m0, %0" : "=&s"(keep) : "v"(gsrc), "s"(lds_dst) : "memory"); }
__device__ __forceinline__ float swapmax(float m) { auto rr = __builtin_amdgcn_permlane32_swap(__float_as_uint(m), __float_as_uint(m), false, false); return fmaxf(__uint_as_float(rr[0]), __uint_as_float(rr[1])); }
__device__ __forceinline__ float swapadd(float m) { auto rr = __builtin_amdgcn_permlane32_swap(__float_as_uint(m), __float_as_uint(m), false, false); return __uint_as_float(rr[0]) + __uint_as_float(rr[1]); }
#define ATT_WAIT_BAR(N) asm volatile("s_waitcnt vmcnt(" #N ") lgkmcnt(0)\n\ts_barrier" ::: "memory")
__device__ __forceinline__ void pv(f32x16* o, int vb, bf16x8 pa0, bf16x8 pa1, bf16x8 pa2, bf16x8 pa3) {
#pragma unroll
    for (int d0 = 0; d0 < 2; ++d0) { s16x4 lo[4], hi[4];
#pragma unroll
        for (int ks = 0; ks < 4; ++ks) {
            asm volatile("ds_read_b64_tr_b16 %0,%1 offset:%c2" : "=&v"(lo[ks]) : "v"(vb), "i"(d0 * 4096 + ks * 1024) : "memory");
            asm volatile("ds_read_b64_tr_b16 %0,%1 offset:%c2" : "=&v"(hi[ks]) : "v"(vb), "i"(d0 * 4096 + ks * 1024 + 512) : "memory"); }
        asm volatile("s_waitcnt lgkmcnt(0)" ::: "memory"); __builtin_amdgcn_sched_barrier(0);
#define ATT_PK(k) (bf16x8){lo[k][0], lo[k][1], lo[k][2], lo[k][3], hi[k][0], hi[k][1], hi[k][2], hi[k][3]}
        o[d0] = __builtin_amdgcn_mfma_f32_32x32x16_bf16(pa0, ATT_PK(0), o[d0], 0, 0, 0);
        o[d0] = __builtin_amdgcn_mfma_f32_32x32x16_bf16(pa1, ATT_PK(1), o[d0], 0, 0, 0);
        o[d0] = __builtin_amdgcn_mfma_f32_32x32x16_bf16(pa2, ATT_PK(2), o[d0], 0, 0, 0);
        o[d0] = __builtin_amdgcn_mfma_f32_32x32x16_bf16(pa3, ATT_PK(3), o[d0], 0, 0, 0);
#undef ATT_PK
    }
}
__device__ __forceinline__ bf16x8 pack8(const f32x16& p, int base) { u32x4 w; w.x = cvt_pk_bf16(p[base], p[base + 1]); w.y = cvt_pk_bf16(p[base + 2], p[base + 3]); w.z = cvt_pk_bf16(p[base + 4], p[base + 5]); w.w = cvt_pk_bf16(p[base + 6], p[base + 7]); return __builtin_bit_cast(bf16x8, w); }

template <int MODE>
__device__ __forceinline__ void unit(LAS unsigned char* shm, const bf16_t* proj, int rowbase, int res, int dil, int q0, int T_lo, int T_hi, int qcol, int kcol, int vcol,
                                     bf16_t* O, int opitch, int ocol, float* lse, int h) {
    int tid_l = threadIdx.x; asm volatile("" : "+v"(tid_l));
    const int tid = tid_l, lane = tid & 63, r32 = lane & 31, hi = lane >> 5; const int wid = __builtin_amdgcn_readfirstlane(tid >> 6);
    const unsigned lds0 = (unsigned)(uintptr_t)shm;
    LAS float* wsf = (LAS float*)(shm + LDS_WS) + wid * 64;
    const size_t tok0 = (size_t)rowbase + res;
    const bf16_t* ksrc = proj + (tok0 + (size_t)dil * lane) * INW + kcol + wid * 8;
    const bf16_t* vsrc = proj + (tok0 + (size_t)dil * (16 * (wid & 3) + (lane >> 2))) * INW + vcol + (wid >> 2) * 32 + (lane & 3) * 8;
    const size_t tstep = (size_t)dil * 64 * INW;
    const unsigned kdst = lds0 + LDS_K + wid * 1024, vdst = lds0 + LDS_V + wid * 1024;
#define ATT_DMA(t, slot) do { glds16(ksrc + (size_t)(t) * tstep, (unsigned)__builtin_amdgcn_readfirstlane(kdst + (slot) * SLOTB)); glds16(vsrc + (size_t)(t) * tstep, (unsigned)__builtin_amdgcn_readfirstlane(vdst + (slot) * SLOTB)); } while (0)
    const int vb0 = (int)(lds0 + LDS_V) + ((lane >> 4) & 1) * 32 + (lane & 3) * 8 + (4 * hi + ((lane & 15) >> 2)) * 64;
    const int qpos = q0 + wid * 32 + r32, qmin = q0 + wid * 32, qmax = qmin + 31;
    const int NT = T_hi - T_lo + 1;
    ATT_DMA(T_hi, 0); if (NT > 1) ATT_DMA(T_hi - 1, 1);
    bf16x8 qr[4];
    { const bf16_t* qp = proj + (tok0 + (size_t)dil * qpos) * INW + qcol + hi * 8;
#pragma unroll
      for (int d0 = 0; d0 < 4; ++d0) qr[d0] = *(const bf16x8*)(qp + d0 * 16); }
    asm volatile("s_waitcnt vmcnt(0)" : "+v"(qr[0]), "+v"(qr[1]), "+v"(qr[2]), "+v"(qr[3]) :: "memory");
    bf16x8 ua0, ua1, ones;
    { u32x4 a, b; unsigned av[8], bv[8];
#pragma unroll
      for (int j = 0; j < 8; ++j) { const int kvk = 8 * (j >> 2) + 4 * hi + (j & 3); av[j] = kvk >= r32 ? 0x3f80u : 0u; bv[j] = kvk + 16 >= r32 ? 0x3f80u : 0u; }
      a.x = av[0] | (av[1] << 16); a.y = av[2] | (av[3] << 16); a.z = av[4] | (av[5] << 16); a.w = av[6] | (av[7] << 16);
      b.x = bv[0] | (bv[1] << 16); b.y = bv[2] | (bv[3] << 16); b.z = bv[4] | (bv[5] << 16); b.w = bv[6] | (bv[7] << 16);
      ua0 = __builtin_bit_cast(bf16x8, a); ua1 = __builtin_bit_cast(bf16x8, b); const u32x4 o1 = {0x3f803f80u, 0x3f803f80u, 0x3f803f80u, 0x3f803f80u}; ones = __builtin_bit_cast(bf16x8, o1); }
    f32x16 o[2]; o[0] = f32x16{}; o[1] = f32x16{};
    float carry = 0.f, mrun = -INFINITY, lrun = 0.f;
    for (int n = 0; n < NT; ++n) { const int kt = T_hi - n; const int slot = n % 3;
        if (n + 1 < NT) ATT_WAIT_BAR(2); else ATT_WAIT_BAR(0);
        if (n + 2 < NT) ATT_DMA(kt - 2, (n + 2) % 3);
        const int kmin = kt * 64, kmax = kmin + 63;
        bool need, full;
        if (MODE == 0) { need = kmin < qmax; full = kmax < qmin; } else { need = (kmin <= qmax) && (kmax >= qmin - 128); full = (kmax <= qmin) && (kmin >= qmax - 128); }
        if (!need) continue;
        f32x16 p0 = f32x16{}, p1 = f32x16{};
        { const LAS unsigned char* kb = shm + LDS_K + slot * SLOTB + hi * 1024 + r32 * 16;
#pragma unroll
          for (int d0 = 0; d0 < 4; ++d0) { const bf16x8 b0 = *(const LAS bf16x8*)(kb + d0 * 2048), b1 = *(const LAS bf16x8*)(kb + d0 * 2048 + 512);
              p0 = __builtin_amdgcn_mfma_f32_32x32x16_bf16(b0, qr[d0], p0, 0, 0, 0); p1 = __builtin_amdgcn_mfma_f32_32x32x16_bf16(b1, qr[d0], p1, 0, 0, 0); } }
        const int kb0 = kmin + 4 * hi;
        if (MODE == 0) {
            f32x16 s0, s1;
#pragma unroll
            for (int r = 0; r < 16; ++r) { const int kv = kb0 + (r & 3) + 8 * (r >> 2);
                p0[r] = fminf(p0[r], 100.f); p1[r] = fminf(p1[r], 100.f);
                float a = lg2(1.f + ex2(p0[r])), b = lg2(1.f + ex2(p1[r]));
                if (!full) { if (kv >= qpos) a = 0.f; if (kv + 32 >= qpos) b = 0.f; }
                s0[r] = a; s1[r] = b; }
            const bf16x8 q0_ = pack8(s0, 0), q1_ = pack8(s0, 8), q2_ = pack8(s1, 0), q3_ = pack8(s1, 8);
            f32x16 c0 = f32x16{}, c1 = f32x16{};
            c0 = __builtin_amdgcn_mfma_f32_32x32x16_bf16(ua0, q0_, c0, 0, 0, 0); c0 = __builtin_amdgcn_mfma_f32_32x32x16_bf16(ua1, q1_, c0, 0, 0, 0);
            c0 = __builtin_amdgcn_mfma_f32_32x32x16_bf16(ones, q2_, c0, 0, 0, 0); c0 = __builtin_amdgcn_mfma_f32_32x32x16_bf16(ones, q3_, c0, 0, 0, 0);
            c1 = __builtin_amdgcn_mfma_f32_32x32x16_bf16(ua0, q2_, c1, 0, 0, 0); c1 = __builtin_amdgcn_mfma_f32_32x32x16_bf16(ua1, q3_, c1, 0, 0, 0);
#pragma unroll
            for (int r = 0; r < 16; ++r) { const int kv = kb0 + (r & 3) + 8 * (r >> 2);
                float a = ex2(p0[r] - c0[r] - carry), b = ex2(p1[r] - c1[r] - carry);
                if (!full) { if (kv >= qpos) a = 0.f; if (kv + 32 >= qpos) b = 0.f; }
                p0[r] = a; p1[r] = b; }
            carry += __shfl(c0[0], r32);
        } else {
            if (!full) {
#pragma unroll
                for (int r = 0; r < 16; ++r) { const int kv = kb0 + (r & 3) + 8 * (r >> 2);
                    if (kv > qpos || kv < qpos - 128) p0[r] = -INFINITY; if (kv + 32 > qpos || kv + 32 < qpos - 128) p1[r] = -INFINITY; } }
            float rm = fmaxf(p0[0], p1[0]);
#pragma unroll
            for (int r = 1; r < 16; ++r) rm = fmaxf(rm, fmaxf(p0[r], p1[r]));
            rm = swapmax(rm);
            const float mnew = fmaxf(mrun, rm), muse = mnew == -INFINITY ? 0.f : mnew, f = ex2(mrun - muse);
            float rs = 0.f;
#pragma unroll
            for (int r = 0; r < 16; ++r) { p0[r] = ex2(p0[r] - muse); p1[r] = ex2(p1[r] - muse); rs += p0[r] + p1[r]; }
            lrun = lrun * f + rs; mrun = mnew;
            if (hi == 0) wsf[r32] = f;
            asm volatile("s_waitcnt lgkmcnt(0)" ::: "memory");
#pragma unroll
            for (int r = 0; r < 16; ++r) { const float fr_ = wsf[crow(r, hi)]; o[0][r] *= fr_; o[1][r] *= fr_; }
        }
        pv(o, vb0 + slot * SLOTB, pack8(p0, 0), pack8(p0, 8), pack8(p1, 0), pack8(p1, 8));
    }
    float rli[16];
    if (MODE == 1) { const float lt = swapadd(lrun); if (hi == 0) { wsf[32 + r32] = lt; lse[(tok0 + (size_t)dil * qpos) * 6 + h] = mrun + lg2(lt); }
        asm volatile("s_waitcnt lgkmcnt(0)" ::: "memory");
#pragma unroll
        for (int r = 0; r < 16; ++r) rli[r] = rcpf_(wsf[32 + crow(r, hi)]); }
    else {
#pragma unroll
        for (int r = 0; r < 16; ++r) rli[r] = 1.f; }
    { LAS bf16_t* stg = (LAS bf16_t*)(shm + LDS_OST) + wid * 2048;
#pragma unroll
      for (int r = 0; r < 16; ++r) { const int orow = crow(r, hi);
#pragma unroll
          for (int d0 = 0; d0 < 2; ++d0) { const unsigned pk = cvt_pk_bf16(o[d0][r] * rli[r], 0.f); stg[orow * 64 + d0 * 32 + r32] = (bf16_t)(pk & 0xffffu); } }
      asm volatile("s_waitcnt lgkmcnt(0)" ::: "memory");
#pragma unroll
      for (int i = 0; i < 4; ++i) { const int row = i * 8 + (lane >> 3), ch = lane & 7; const u32x4 v = *(const LAS u32x4*)(stg + row * 64 + ch * 8);
          *(u32x4*)(O + (tok0 + (size_t)dil * (qmin + row)) * opitch + ocol + ch * 8) = v; } }
    asm volatile("s_waitcnt lgkmcnt(0)\n\ts_barrier" ::: "memory");
#undef ATT_DMA
}
constexpr float SB_TAU = 48.f;
__device__ __forceinline__ void unit_sb(LAS unsigned char* shm, const bf16_t* proj, int rowbase, int q0, int T_hi, int qcol, int kcol, int vcol, bf16_t* O, int opitch, int ocol) {
    int tid_l = threadIdx.x; asm volatile("" : "+v"(tid_l));
    const int tid = tid_l, lane = tid & 63, r32 = lane & 31, hi = lane >> 5; const int wid = __builtin_amdgcn_readfirstlane(tid >> 6);
    const unsigned lds0 = (unsigned)(uintptr_t)shm;
    const size_t tok0 = (size_t)rowbase;
    const bf16_t* ksrc = proj + (tok0 + lane) * INW + kcol + wid * 8;
    const bf16_t* vsrc = proj + (tok0 + (16 * (wid & 3) + (lane >> 2))) * INW + vcol + (wid >> 2) * 32 + (lane & 3) * 8;
    const size_t tstep = (size_t)64 * INW;
    const unsigned kdst = lds0 + LDS_K + wid * 1024, vdst = lds0 + LDS_V + wid * 1024;
    const int NT = T_hi + 1;
#define SB_DMAK(n) do { const int n_ = (n) < NT ? (n) : NT - 1; glds16(ksrc + (size_t)(T_hi - n_) * tstep, (unsigned)__builtin_amdgcn_readfirstlane(kdst + ((n) % 3) * SLOTB)); } while (0)
#define SB_DMAV(n) do { const int n_ = (n) < NT ? (n) : NT - 1; glds16(vsrc + (size_t)(T_hi - n_) * tstep, (unsigned)__builtin_amdgcn_readfirstlane(vdst + ((n) % 3) * SLOTB)); } while (0)
    const int vb0 = (int)(lds0 + LDS_V) + ((lane >> 4) & 1) * 32 + (lane & 3) * 8 + (4 * hi + ((lane & 15) >> 2)) * 64;
    const int qpos = q0 + wid * 32 + r32, qmin = q0 + wid * 32, qmax = qmin + 31;
    SB_DMAK(0); SB_DMAK(1); SB_DMAV(0); SB_DMAK(2); SB_DMAV(1);
    bf16x8 qr[4];
    { const bf16_t* qp = proj + (tok0 + qpos) * INW + qcol + hi * 8;
#pragma unroll
      for (int d0 = 0; d0 < 4; ++d0) qr[d0] = *(const bf16x8*)(qp + d0 * 16); }
    bf16x8 ua0, ua1, ones;
    { u32x4 a, b; unsigned av[8], bv[8];
#pragma unroll
      for (int j = 0; j < 8; ++j) { const int kvk = 8 * (j >> 2) + 4 * hi + (j & 3); av[j] = kvk >= r32 ? 0x3f80u : 0u; bv[j] = kvk + 16 >= r32 ? 0x3f80u : 0u; }
      a.x = av[0] | (av[1] << 16); a.y = av[2] | (av[3] << 16); a.z = av[4] | (av[5] << 16); a.w = av[6] | (av[7] << 16);
      b.x = bv[0] | (bv[1] << 16); b.y = bv[2] | (bv[3] << 16); b.z = bv[4] | (bv[5] << 16); b.w = bv[6] | (bv[7] << 16);
      ua0 = __builtin_bit_cast(bf16x8, a); ua1 = __builtin_bit_cast(bf16x8, b); const u32x4 o1 = {0x3f803f80u, 0x3f803f80u, 0x3f803f80u, 0x3f803f80u}; ones = __builtin_bit_cast(bf16x8, o1); }
    f32x16 o[2]; o[0] = f32x16{}; o[1] = f32x16{};
    float carry = 0.f;
#define SB_STAGE_A(n, d0_, d1_, tot_) do { const int kmin_ = (T_hi - (n)) * 64; const bool full_ = kmin_ + 63 < qmin; const int kb0_ = kmin_ + 4 * hi; \
        f32x16 p0_ = f32x16{}, p1_ = f32x16{}; \
        { const LAS unsigned char* kb_ = shm + LDS_K + ((n) % 3) * SLOTB + hi * 1024 + r32 * 16; \
          _Pragma("unroll") for (int dd = 0; dd < 4; ++dd) { const bf16x8 b0 = *(const LAS bf16x8*)(kb_ + dd * 2048), b1 = *(const LAS bf16x8*)(kb_ + dd * 2048 + 512); \
              p0_ = __builtin_amdgcn_mfma_f32_32x32x16_bf16(b0, qr[dd], p0_, 0, 0, 0); p1_ = __builtin_amdgcn_mfma_f32_32x32x16_bf16(b1, qr[dd], p1_, 0, 0, 0); } } \
        f32x16 s0_, s1_; \
        _Pragma("unroll") for (int r = 0; r < 16; ++r) { const int kv = kb0_ + (r & 3) + 8 * (r >> 2); \
            p0_[r] = fminf(p0_[r], 100.f); p1_[r] = fminf(p1_[r], 100.f); \
            float a_ = lg2(1.f + ex2(p0_[r])), b_ = lg2(1.f + ex2(p1_[r])); \
            if (!full_) { if (kv >= qpos) { a_ = 0.f; p0_[r] = -INFINITY; } if (kv + 32 >= qpos) { b_ = 0.f; p1_[r] = -INFINITY; } } \
            s0_[r] = a_; s1_[r] = b_; } \
        const bf16x8 q0_ = pack8(s0_, 0), q1_ = pack8(s0_, 8), q2_ = pack8(s1_, 0), q3_ = pack8(s1_, 8); \
        f32x16 c0_ = f32x16{}, c1_ = f32x16{}; \
        c0_ = __builtin_amdgcn_mfma_f32_32x32x16_bf16(ua0, q0_, c0_, 0, 0, 0); c1_ = __builtin_amdgcn_mfma_f32_32x32x16_bf16(ua0, q2_, c1_, 0, 0, 0); \
        c0_ = __builtin_amdgcn_mfma_f32_32x32x16_bf16(ua1, q1_, c0_, 0, 0, 0); c1_ = __builtin_amdgcn_mfma_f32_32x32x16_bf16(ua1, q3_, c1_, 0, 0, 0); \
        c0_ = __builtin_amdgcn_mfma_f32_32x32x16_bf16(ones, q2_, c0_, 0, 0, 0); c0_ = __builtin_amdgcn_mfma_f32_32x32x16_bf16(ones, q3_, c0_, 0, 0, 0); \
        _Pragma("unroll") for (int r = 0; r < 16; ++r) { d0_[r] = p0_[r] - c0_[r]; d1_[r] = p1_[r] - c1_[r]; } \
        tot_ = __shfl(c0_[0], r32); } while (0)
    f32x16 dC0 = f32x16{}, dC1 = f32x16{}; float totC = 0.f;
    asm volatile("s_waitcnt vmcnt(0)\n\ts_barrier" : "+v"(qr[0]), "+v"(qr[1]), "+v"(qr[2]), "+v"(qr[3]) :: "memory");
    bool needC = (T_hi * 64) < qmax;
    if (needC) SB_STAGE_A(0, dC0, dC1, totC);
    LAS unsigned* flagp = (LAS unsigned*)(shm + LDS_WS);
    for (int n = 0; n < NT; ++n) {
        ATT_WAIT_BAR(2);
        if (n > 0) { const unsigned f = flagp[(lane & 7) * 64 + 60 + ((n - 1) & 1)]; if (__builtin_amdgcn_ballot_w64(f != 0u) == ~0ull) break; }
        SB_DMAK(n + 3); SB_DMAV(n + 2);
        f32x16 dN0 = f32x16{}, dN1 = f32x16{}; float totN = 0.f;
        const bool needN = (n + 1 < NT) && ((T_hi - (n + 1)) * 64 < qmax);
        if (needN) SB_STAGE_A(n + 1, dN0, dN1, totN);
        if (needC) {
#pragma unroll
            for (int r = 0; r < 16; ++r) { dC0[r] = ex2(dC0[r] - carry); dC1[r] = ex2(dC1[r] - carry); }
            carry += totC;
            pv(o, vb0 + (n % 3) * SLOTB, pack8(dC0, 0), pack8(dC0, 8), pack8(dC1, 0), pack8(dC1, 8));
        }
        { const bool sat = __builtin_amdgcn_ballot_w64(carry >= SB_TAU) == ~0ull; if (lane == 0) flagp[wid * 64 + 60 + (n & 1)] = sat ? 1u : 0u; }
        dC0 = dN0; dC1 = dN1; totC = totN; needC = needN;
    }
    asm volatile("s_waitcnt vmcnt(0)" ::: "memory");
    { LAS bf16_t* stg = (LAS bf16_t*)(shm + LDS_OST) + wid * 2048;
#pragma unroll
      for (int r = 0; r < 16; ++r) { const int orow = crow(r, hi);
#pragma unroll
          for (int d0 = 0; d0 < 2; ++d0) { const unsigned pk = cvt_pk_bf16(o[d0][r], 0.f); stg[orow * 64 + d0 * 32 + r32] = (bf16_t)(pk & 0xffffu); } }
      asm volatile("s_waitcnt lgkmcnt(0)" ::: "memory");
#pragma unroll
      for (int i = 0; i < 4; ++i) { const int row = i * 8 + (lane >> 3), ch = lane & 7; const u32x4 v = *(const LAS u32x4*)(stg + row * 64 + ch * 8);
          *(u32x4*)(O + (tok0 + (qmin + row)) * opitch + ocol + ch * 8) = v; } }
    asm volatile("s_waitcnt lgkmcnt(0)\n\ts_barrier" ::: "memory");
#undef SB_DMAK
#undef SB_DMAV
#undef SB_STAGE_A
}
#undef ATT_WAIT_BAR
}
#define RTAB_BUILD(So_, ssp_) do { int tq_ = threadIdx.x; asm volatile("" : "+v"(tq_)); Unit uq_; \
    for (int i_ = __builtin_amdgcn_readfirstlane(tq_ >> 8); i_ < RTAB_UNITS && (So_).next(i_, uq_); i_ += 2) ((LAS float*)(lds + RTAB_OFF))[i_ * 256 + (tq_ & 255)] = row_rs((ssp_), (unsigned)(uq_.pm * 256 + (tq_ & 255))); \
    __syncthreads(); } while (0)
__global__ void __launch_bounds__(512, 2) fwd_mega(Args a) {
    extern __shared__ __attribute__((aligned(16))) unsigned char lds_raw[];
    LAS unsigned char* lds = (LAS unsigned char*)lds_raw;
    float* smf = (float*)lds_raw;
    cg::grid_group grid = cg::this_grid();
    const int tid = threadIdx.x, lane = tid & 63, wave = __builtin_amdgcn_readfirstlane(tid >> 6);
    const int G = gridDim.x, bid = blockIdx.x, gw = bid * 8 + wave, NGW = G * 8, gt = bid * 512 + tid, NGT = G * 512;
    const float* x = a.in[0]; const float* c = a.in[1]; const int* pos = (const int*)a.in[2]; const float* w_ada = a.in[3]; const float* b_ada = a.in[4];
    const float* g_mix = a.in[5]; const float* w_in = a.in[6]; const float* g_sgu = a.in[7]; const float* w_sp = a.in[8]; const float* b_sp = a.in[9];
    const float* w_out = a.in[10]; const float* g_ffn = a.in[11]; const float* w_up = a.in[12]; const float* conv_w = a.in[13]; const float* conv_b = a.in[14];
    const float* w_down = a.in[15]; const float* g_final = a.in[16];
    float* out = a.out; unsigned char* ws = a.ws;
    unsigned* ctl = (unsigned*)(ws + WS_CTL);
    float* mod = (float*)(ws + WS_MOD); float* sw1 = (float*)(ws + WS_SW1); float* sw2 = (float*)(ws + WS_SW2); float* ssb = (float*)(ws + WS_SSP);
    float* ct = (float*)(ws + WS_CT); float* st = (float*)(ws + WS_ST); float* lse = (float*)(ws + WS_LSE); float* lastU = (float*)(ws + WS_LASTU); float* firstU = (float*)(ws + WS_FIRSTU);
    bf16_t* ycraw = (bf16_t*)(ws + WS_YC); bf16_t* Wt_in = (bf16_t*)(ws + WS_WIN); bf16_t* Wt_out = (bf16_t*)(ws + WS_WOUT); bf16_t* Wt_up = (bf16_t*)(ws + WS_WUP); bf16_t* Wt_dn = (bf16_t*)(ws + WS_WDN);
    bf16_t* hA = (bf16_t*)(ws + WS_HA); bf16_t* proj = (bf16_t*)(ws + WS_PROJ); bf16_t* ymix = (bf16_t*)(ws + WS_YMIX); bf16_t* gbuf = (bf16_t*)(ws + WS_G);

    unsigned* bcnt = (unsigned*)(ws + WS_CTL) + 64; unsigned epoch = 0u;
    { volatile LAS unsigned* stz = (volatile LAS unsigned*)(lds + RING_BYTES + 2048); if (tid < 2) stz[tid] = 0u; __syncthreads(); }
    const XcdBarrier xbar = xcd_barrier_post((unsigned*)(ws + WS_CTL + 8192), (volatile LAS unsigned*)(lds + RING_BYTES + 2048));
    grid.sync();
    if (bid == 0 && tid < 16) ctl[tid] = 0u;
    for (int i = gt; i < M * 32; i += NGT) { const int r = i >> 5, f = i & 31; const float inv = (float)pow(10000.0, -(double)f / 32.0); const float ang = (float)pos[r] * inv;
        ct[i] = (float)cos((double)ang); st[i] = (float)sin((double)ang); }
    for (int it = bid; it < 4 * 96; it += G) { const int l = it / 96, j0 = (it % 96) * 64;
        const float s = gemv_item<true>(smf, tid, c, D, w_ada + (size_t)l * D * NMOD, NMOD, j0);
        if (tid < 256) { const int b = tid >> 6, j = j0 + (tid & 63); mod[(size_t)(l * 4 + b) * NMOD + j] = s + b_ada[(size_t)l * NMOD + j]; }
        __syncthreads(); }
    { float* scr = smf + wave * 4096;
      for (int it = gw; it < 4 * 6144; it += NGW) { const int l = it / 6144; int r = it % 6144;
          if (r < 1408) { const int kb = r / 88, nb = r % 88; transpose_item(w_in + (size_t)l * D * INW, D, INW, Wt_in + (size_t)l * INW * D, kb * 64, nb * 32, phys_in(nb * 32), scr, lane); continue; } r -= 1408;
          if (r < 512) { const int kb = r / 32, nb = r % 32; transpose_item(w_out + (size_t)l * D * D, D, D, Wt_out + (size_t)l * D * D, kb * 64, nb * 32, nb * 32, scr, lane); continue; } r -= 512;
          if (r < 2816) { const int kb = r / 176, nb = r % 176; transpose_item(w_up + (size_t)l * D * FF2, D, FF2, Wt_up + (size_t)l * FF2 * D, kb * 64, nb * 32, phys_up(nb * 32), scr, lane); continue; } r -= 2816;
          { const int kb = r / 32, nb = r % 32; transpose_item(w_down + (size_t)l * FF * D, FF, D, Wt_dn + (size_t)l * D * FF, kb * 64, nb * 32, nb * 32, scr, lane); } } }
    xcd_barrier(xbar);
    for (int it = bid; it < 4 * 132; it += G) { const int l = it / 132; int r = it % 132;
        if (r < 44) { const int j0 = r * 64; const float s = gemv_item<false>(smf, tid, mod + (size_t)l * 4 * NMOD, NMOD, w_in + (size_t)l * D * INW, INW, j0);
            if (tid < 256) { const int b = tid >> 6, j = j0 + (tid & 63); sw1[(size_t)(l * 4 + b) * INW + phys_in(j & ~31) + (j & 31)] = s; } }
        else { r -= 44; const int j0 = r * 64; const float s = gemv_item<false>(smf, tid, mod + (size_t)l * 4 * NMOD + 3 * D, NMOD, w_up + (size_t)l * D * FF2, FF2, j0);
            if (tid < 256) { const int b = tid >> 6, j = j0 + (tid & 63); sw2[(size_t)(l * 4 + b) * FF2 + phys_up(j & ~31) + (j & 31)] = s; } }
        __syncthreads(); }
    for (int row = gw; row < M; row += NGW) { const int b = row / S; const f32x4* xr = (const f32x4*)(x + (size_t)row * D) + lane; float s2 = 0.f;
#pragma unroll
        for (int j = 0; j < 4; ++j) { const f32x4 v = xr[64 * j]; const int col = 4 * (lane + 64 * j); s2 += (v[0] * v[0] + v[1] * v[1]) + (v[2] * v[2] + v[3] * v[3]);
            const f32x4 gs = *(const f32x4*)(g_mix + col) * (*(const f32x4*)(mod + (size_t)b * NMOD + D + col) + 1.f); const f32x4 o = v * gs;
            u32x2 w; w.x = cvt_pk_bf16(o[0], o[1]); w.y = cvt_pk_bf16(o[2], o[3]); *(u32x2*)(hA + (size_t)row * D + col) = w; }
#pragma unroll
        for (int o = 1; o < 64; o <<= 1) s2 += __shfl_xor(s2, o);
        if (lane < 16) ssb[(size_t)row * 16 + lane] = lane == 0 ? s2 : 0.f; }
    xcd_barrier(xbar);

    for (int l = 0; l < DEPTH; ++l) {
        const float* modl = mod + (size_t)l * 4 * NMOD;
        { pg8::Gemm g{hA, Wt_in + (size_t)l * INW * D, M, INW, D}; pg8::StaticOrder So; So.init(M, INW, G, bid);
          RTAB_BUILD(So, ssb + (size_t)(2 * l) * M * 16);
          EpiIn E{proj, (const LAS float*)(lds + RTAB_OFF), sw1 + (size_t)l * 4 * INW, ct, st};
          pg8::gemm_phase<EpiIn, pg8::StaticOrder, true, true>(lds, g, So, E); }
        xcd_barrier(xbar);
        { int tp = threadIdx.x; asm volatile("" : "+v"(tp));
          volatile unsigned* slot = (volatile unsigned*)(lds_raw + RING_BYTES + 1024);
          if (tp == 0) *slot = atomicAdd(ctl + l, 1u);
          __syncthreads();
          int idx = (int)*slot;
          __syncthreads();
          while (idx < 1280) {
              unsigned nxt = 0u; if (tp == 0) nxt = atomicAdd(ctl + l, 1u);
              if (idx < 384) { const int qb = 15 - idx / 24, bh = idx % 24, b = bh / 6, h = bh % 6;
                  att::unit_sb(lds, proj, b * S, qb * 256, 4 * qb + 3, 512 + h * 64, 896 + h * 64, 1280 + h * 64, ymix, D, 256 + h * 64); }
              else if (idx < 768) { const int j = idx - 384, bh = j % 24, b = bh / 6, h = bh % 6, uidx = j / 24, dil = h < 2 ? 1 : (h < 4 ? 4 : 16), nq = (S / dil) / 256, res = uidx / nq, qb = uidx % nq;
                  att::unit<1>(lds, proj, b * S, res, dil, qb * 256, 4 * qb - 2 < 0 ? 0 : 4 * qb - 2, 4 * qb + 3, 1664 + h * 64, 2048 + h * 64, 2432 + h * 64, ycraw, 384, h * 64, lse, h); }
              else mix_a_unit_mfma(lds_raw, tp, idx - 768, proj, g_sgu + l * 256, w_sp + (size_t)l * 4 * 128 * 128, b_sp + l * 4 * 128, ymix);
              if (tp == 0) *slot = nxt;
              __syncthreads();
              idx = (int)*slot;
              __syncthreads();
          } }
        xcd_barrier(xbar);
        { int tp = threadIdx.x; asm volatile("" : "+v"(tp)); const int lanep = tp & 63, gwp = bid * 8 + (tp >> 6);
          if (lanep < 48) { const int h = lanep >> 3, jj = h & 1;
              for (int row0 = gwp; row0 < M; row0 += 4 * NGW) {
                  float l0[4], l1[4], l2[4]; u32x4 v[4];
#pragma unroll
                  for (int k = 0; k < 4; ++k) { const int row = row0 + k * NGW; if (row < M) { l0[k] = lse[(size_t)row * 6 + jj]; l1[k] = lse[(size_t)row * 6 + 2 + jj]; l2[k] = lse[(size_t)row * 6 + 4 + jj]; v[k] = *(const u32x4*)(ycraw + (size_t)row * 384 + lanep * 8); } }
#pragma unroll
                  for (int k = 0; k < 4; ++k) { const int row = row0 + k * NGW; if (row < M) {
                      const float mm = fmaxf(l0[k], fmaxf(l1[k], l2[k])), e0 = ex2(l0[k] - mm), e1 = ex2(l1[k] - mm), e2 = ex2(l2[k] - mm); const float al = ((h >> 1) == 0 ? e0 : ((h >> 1) == 1 ? e1 : e2)) / (e0 + e1 + e2); u32x4 w;
                      w.x = cvt_pk_bf16(bf_lo(v[k].x) * al, bf_hi(v[k].x) * al); w.y = cvt_pk_bf16(bf_lo(v[k].y) * al, bf_hi(v[k].y) * al); w.z = cvt_pk_bf16(bf_lo(v[k].z) * al, bf_hi(v[k].z) * al); w.w = cvt_pk_bf16(bf_lo(v[k].w) * al, bf_hi(v[k].w) * al);
                      *(u32x4*)(ymix + (size_t)row * D + 640 + lanep * 8) = w; } } } } }
        xcd_barrier(xbar);
        { pg8::StaticOrder So; So.init(M, D, G, bid);
          pg8::Gemm g{ymix, Wt_out + (size_t)l * D * D, M, D, D};
          EpiRes E{l == 0 ? x : out, out, modl + 2 * D, ssb + (size_t)(2 * l + 1) * M * 16, g_ffn + l * D, modl + 4 * D, hA};
          pg8::gemm_phase<EpiRes, pg8::StaticOrder, true, true>(lds, g, So, E); }
        xcd_barrier(xbar);
        { pg8::Gemm g{hA, Wt_up + (size_t)l * FF2 * D, M, FF2, D}; pg8::StaticOrder So; So.init(M, FF2, G, bid);
          RTAB_BUILD(So, ssb + (size_t)(2 * l + 1) * M * 16);
          EpiUc E{gbuf, (const LAS float*)(lds + RTAB_OFF), sw2 + (size_t)l * 4 * FF2, conv_w + (size_t)l * 3 * FF2, conv_b + (size_t)l * FF2, lastU, firstU, proj + (size_t)bid * 131072};
          pg8::gemm_phase<EpiUc, pg8::StaticOrder, true, true>(lds, g, So, E); }
        xcd_barrier(xbar);
        { pg8::StaticOrder So; So.init(M, D, G, bid); Unit u;
          const float* cw = conv_w + (size_t)l * 3 * FF2; const float* cb = conv_b + (size_t)l * FF2;
          int tp = threadIdx.x; asm volatile("" : "+v"(tp));
          for (int i = 0; So.next(i, u); ++i) { if ((u.pm & 15) == 0) continue;
              for (int q = tp; q < FF / 4; q += 512) { const int n = q * 4, pc = (n >> 7) * 256 + (n & 127);
                  const float* f0 = firstU + ((size_t)u.pm * 2) * FF2 + pc; const float* l0 = lastU + ((size_t)(u.pm - 1) * 2) * FF2 + pc;
                  const f32x4 lg0 = *(const f32x4*)l0, lg1 = *(const f32x4*)(l0 + FF2), fg0 = *(const f32x4*)f0, fg1 = *(const f32x4*)(f0 + FF2);
                  const f32x4 lv0 = *(const f32x4*)(l0 + 128), lv1 = *(const f32x4*)(l0 + FF2 + 128), fv0 = *(const f32x4*)(f0 + 128), fv1 = *(const f32x4*)(f0 + FF2 + 128);
                  const f32x4 wg0 = *(const f32x4*)(cw + n), wg1 = *(const f32x4*)(cw + FF2 + n), wg2 = *(const f32x4*)(cw + 2 * FF2 + n), bg = *(const f32x4*)(cb + n);
                  const f32x4 wv0 = *(const f32x4*)(cw + FF + n), wv1 = *(const f32x4*)(cw + FF2 + FF + n), wv2 = *(const f32x4*)(cw + 2 * FF2 + FF + n), bv = *(const f32x4*)(cb + FF + n);
                  const f32x4 og0 = bg + wg0 * lg0 + wg1 * lg1 + wg2 * fg0, ov0 = bv + wv0 * lv0 + wv1 * lv1 + wv2 * fv0;
                  const f32x4 og1 = bg + wg0 * lg1 + wg1 * fg0 + wg2 * fg1, ov1 = bv + wv0 * lv1 + wv1 * fv0 + wv2 * fv1;
                  u32x2 w0_, w1_;
                  w0_.x = cvt_pk_bf16(silu_(og0[0]) * ov0[0], silu_(og0[1]) * ov0[1]); w0_.y = cvt_pk_bf16(silu_(og0[2]) * ov0[2], silu_(og0[3]) * ov0[3]);
                  w1_.x = cvt_pk_bf16(silu_(og1[0]) * ov1[0], silu_(og1[1]) * ov1[1]); w1_.y = cvt_pk_bf16(silu_(og1[2]) * ov1[2], silu_(og1[3]) * ov1[3]);
                  *(u32x2*)(gbuf + (size_t)(u.pm * 256) * FF + n) = w0_; *(u32x2*)(gbuf + (size_t)(u.pm * 256 + 1) * FF + n) = w1_; } }
          asm volatile("s_waitcnt vmcnt(0)" ::: "memory"); __syncthreads();
          pg8::Gemm g{gbuf, Wt_dn + (size_t)l * D * FF, M, D, FF};
          EpiRes E{out, out, modl + 5 * D, ssb + (size_t)(2 * l + 2) * M * 16, l + 1 < DEPTH ? g_mix + (l + 1) * D : nullptr, mod + (size_t)(l + 1 < DEPTH ? l + 1 : l) * 4 * NMOD + D, hA};
          pg8::gemm_phase<EpiRes, pg8::StaticOrder, true, true>(lds, g, So, E); }
        xcd_barrier(xbar);
    }
    int tf = threadIdx.x; asm volatile("" : "+v"(tf)); const int lanef = tf & 63, gwf = bid * 8 + (tf >> 6);
    for (int row = gwf; row < M; row += NGW) { const float r = row_rs(ssb + (size_t)8 * M * 16, (unsigned)row); f32x4* xr = (f32x4*)(out + (size_t)row * D) + lanef;
#pragma unroll
        for (int j = 0; j < 4; ++j) { const int col = 4 * (lanef + 64 * j); xr[64 * j] = xr[64 * j] * r * *(const f32x4*)(g_final + col); } }
}

extern "C" void kernel_launch(void* const* d_in, const int* in_sizes, int n_in, void* d_out, int out_size, void* d_ws, size_t ws_size, hipStream_t stream) {
    static int grid = 0;
    if (grid == 0) {
        if (n_in != 17 || out_size != M * D || ws_size < WS_END) { fprintf(stderr, "kernel_launch: unexpected shapes (n_in %d out %d ws %zu)\n", n_in, out_size, ws_size); grid = -1; return; }
        int dev = 0, cus = 0, per_cu = 0;
        hipGetDevice(&dev); hipDeviceGetAttribute(&cus, hipDeviceAttributeMultiprocessorCount, dev);
        hipFuncSetAttribute((const void*)fwd_mega, hipFuncAttributeMaxDynamicSharedMemorySize, LDS_BYTES);
        hipOccupancyMaxActiveBlocksPerMultiprocessor(&per_cu, (const void*)fwd_mega, 512, LDS_BYTES);
        if (per_cu < 1) per_cu = 1;
        grid = cus * per_cu;
    }
    if (grid < 0) return;
    hipMemsetAsync((char*)d_ws + WS_CTL, 0, 32768, stream);
    Args a{};
    for (int i = 0; i < 17; ++i) a.in[i] = (const float*)d_in[i];
    a.out = (float*)d_out; a.ws = (unsigned char*)d_ws;
    void* args[] = {&a};
    hipError_t e = hipLaunchCooperativeKernel((const void*)fwd_mega, dim3(grid), dim3(512), args, LDS_BYTES, stream);
    if (e != hipSuccess) fprintf(stderr, "cooperative launch failed: %s (grid %d)\n", hipGetErrorString(e), grid);
}
```
